# Optimizing an MI355X kernel written in HIP

```python
import jax, jax.numpy as jnp
from jax import lax
import numpy as np

D_MODEL = 1024
BATCH = 32
SEQ = 256
DEPTH = 1
DEC_BATCH = 8
DEC_SEQ = 4096
PAST_LEN = 512

GRID_W = 64
D_RNN = 1024
RNN_HEADS = 16
RNN_HEAD_DIM = D_RNN // RNN_HEADS
CONV_W = 4
CONV_LEFT = 2
LRU_C = 8.0
D_GMLP = 1024
GMLP_GROUPS = 8
GMLP_GROUP_DIM = D_GMLP // GMLP_GROUPS
CHUNK = 128
D_FF = 2816
N_MOD = 9
EPS = 1e-6
IN_COLS = 2 * D_RNN + 2 * D_GMLP + 2 * D_MODEL
IN_SPLITS = (D_RNN, 2 * D_RNN, 2 * D_RNN + D_GMLP, 2 * D_RNN + 2 * D_GMLP,
             2 * D_RNN + 2 * D_GMLP + D_MODEL)

kernel_name = "hybrid_rglru_gmlp_diffusion_step"


def rms_norm(x, g):
    xf = x.astype(jnp.float32)
    y = xf * lax.rsqrt(jnp.mean(xf * xf, axis=-1, keepdims=True) + EPS)
    return (y * g.astype(jnp.float32)).astype(x.dtype)


def modulate(x, g, shift, scale):
    return rms_norm(x, g) * (1 + scale) + shift


def grid_pos_embed(n_tokens, dtype):
    rows = n_tokens // GRID_W
    t = jnp.arange(rows * GRID_W)
    r = (t // GRID_W).astype(jnp.float32)
    col = (t % GRID_W).astype(jnp.float32)
    q = D_MODEL // 4
    freqs = 1.0 / (10000.0 ** (jnp.arange(q, dtype=jnp.float32) / q))
    ang_r = r[:, None] * freqs
    ang_c = col[:, None] * freqs
    pe = jnp.concatenate([jnp.sin(ang_r), jnp.cos(ang_r), jnp.sin(ang_c), jnp.cos(ang_c)], axis=-1)
    return pe.astype(dtype)


def swiglu(x, w_gate, w_up, w_down):
    return (jax.nn.silu(x @ w_gate) * (x @ w_up)) @ w_down


def centred_dwconv(x, w, b):
    T = x.shape[1]
    xp = jnp.pad(x, ((0, 0), (CONV_LEFT, CONV_W - 1 - CONV_LEFT), (0, 0)))
    out = xp[:, 0:T] * w[0]
    for k in range(1, CONV_W):
        out = out + xp[:, k:k + T] * w[k]
    return out + b


def _lru_combine(lhs, rhs):
    a1, b1 = lhs
    a2, b2 = rhs
    return a1 * a2, a2 * b1 + b2


def rg_lru(x, h0, w_r, b_r, w_i, b_i, lam, reverse):
    B, T, _ = x.shape
    xh = x.reshape(B, T, RNN_HEADS, RNN_HEAD_DIM)
    r = jax.nn.sigmoid(jnp.einsum('bthi,hij->bthj', xh, w_r).reshape(B, T, D_RNN) + b_r)
    i = jax.nn.sigmoid(jnp.einsum('bthi,hij->bthj', xh, w_i).reshape(B, T, D_RNN) + b_i)
    log_a = (LRU_C * r.astype(jnp.float32)) * jax.nn.log_sigmoid(lam.astype(jnp.float32))
    a = jnp.exp(log_a)
    mult = jnp.sqrt(jnp.maximum(-jnp.expm1(2.0 * log_a), 0.0))
    bx = mult * (i * x).astype(jnp.float32)
    a_cum, b_cum = lax.associative_scan(_lru_combine, (a, bx), reverse=reverse, axis=1)
    h = a_cum * h0[:, None].astype(jnp.float32) + b_cum
    return h.astype(x.dtype)


def chunk_gmlp(u, v, g_v, w_s, b_s):
    B, T, _ = v.shape
    n = T // CHUNK
    vn = rms_norm(v, g_v).reshape(B, n, CHUNK, GMLP_GROUPS, GMLP_GROUP_DIM)
    mixed = jnp.einsum('gpq,bnqgc->bnpgc', w_s, vn) + b_s.T[None, None, :, :, None]
    return u * mixed.reshape(B, T, D_GMLP)


def mixer(h, h0_f, h0_b, p):
    z = h @ p['w_in']
    xr, gr, u, v, ga, gb = jnp.split(z, IN_SPLITS, axis=-1)
    xr = centred_dwconv(xr, p['conv_w'], p['conv_b'])
    hf = rg_lru(xr, h0_f, p['w_r'][0], p['b_r'][0], p['w_i'][0], p['b_i'][0], p['lam'][0], False)
    hb = rg_lru(xr, h0_b, p['w_r'][1], p['b_r'][1], p['w_i'][1], p['b_i'][1], p['lam'][1], True)
    y_rnn = jax.nn.gelu(gr) * (hf + hb)
    y_g = chunk_gmlp(jax.nn.gelu(u), jax.nn.gelu(v), p['gmlp_norm'], p['w_s'], p['b_s'])
    merged = jax.nn.sigmoid(ga) * (y_rnn @ p['w_br']) + jax.nn.sigmoid(gb) * (y_g @ p['w_bg'])
    return merged @ p['w_out'], hf[:, -1], hb[:, 0]


def trunk_layer(x, cond, h0_f, h0_b, p):
    m = (jax.nn.silu(cond) @ p['w_mod'] + p['b_mod']).reshape(cond.shape[0], N_MOD, 1, D_MODEL)
    sh1, sc1, g1 = m[:, 0], m[:, 1], m[:, 2]
    sh2, sc2, g2 = m[:, 3], m[:, 4], m[:, 5]
    sh3, sc3, g3 = m[:, 6], m[:, 7], m[:, 8]
    x = x + 0.5 * g1 * swiglu(modulate(x, p['norm1'], sh1, sc1), p['ff1_gate'], p['ff1_up'], p['ff1_down'])
    y, hf, hb = mixer(modulate(x, p['norm2'], sh2, sc2), h0_f, h0_b, p)
    x = x + g2 * y
    x = x + 0.5 * g3 * swiglu(modulate(x, p['norm3'], sh3, sc3), p['ff2_gate'], p['ff2_up'], p['ff2_down'])
    return x, hf, hb


def setup_inputs(seed: int = 0) -> dict:
    key = jax.random.key(seed)
    ks = jax.random.split(key, 40)
    nrm = lambda k, shape, s: jax.random.normal(k, shape, jnp.float32) * s
    gain = lambda k, shape: 1.0 + 0.02 * jax.random.normal(k, shape, jnp.float32)
    L = DEPTH
    a0 = jax.random.uniform(ks[18], (L, 2, D_RNN), jnp.float32, 0.9, 0.999)
    return {
        "x_prompt": nrm(ks[0], (BATCH, SEQ, D_MODEL), 1.0),
        "x_sample": nrm(ks[1], (DEC_BATCH, DEC_SEQ, D_MODEL), 1.0),
        "state_rnn_fwd": nrm(ks[2], (DEC_BATCH, DEPTH, D_RNN), 1.0),
        "state_rnn_bwd": nrm(ks[3], (DEC_BATCH, DEPTH, D_RNN), 1.0),
        "c": nrm(ks[4], (DEC_BATCH, D_MODEL), 1.0),
        "c_ctx": nrm(ks[5], (D_MODEL,), 1.0),
        "w_mod": nrm(ks[6], (L, D_MODEL, N_MOD * D_MODEL), D_MODEL ** -0.5),
        "b_mod": nrm(ks[7], (L, N_MOD * D_MODEL), 0.02),
        "norm1": gain(ks[8], (L, D_MODEL)),
        "norm2": gain(ks[9], (L, D_MODEL)),
        "norm3": gain(ks[10], (L, D_MODEL)),
        "ff1_gate": nrm(ks[11], (L, D_MODEL, D_FF), D_MODEL ** -0.5),
        "ff1_up": nrm(ks[12], (L, D_MODEL, D_FF), D_MODEL ** -0.5),
        "ff1_down": nrm(ks[13], (L, D_FF, D_MODEL), D_FF ** -0.5),
        "w_in": nrm(ks[14], (L, D_MODEL, IN_COLS), D_MODEL ** -0.5),
        "conv_w": nrm(ks[15], (L, CONV_W, D_RNN), CONV_W ** -0.5),
        "conv_b": nrm(ks[16], (L, D_RNN), 0.02),
        "w_r": nrm(ks[17], (L, 2, RNN_HEADS, RNN_HEAD_DIM, RNN_HEAD_DIM), RNN_HEAD_DIM ** -0.5),
        "b_r": nrm(ks[19], (L, 2, D_RNN), 0.02),
        "w_i": nrm(ks[20], (L, 2, RNN_HEADS, RNN_HEAD_DIM, RNN_HEAD_DIM), RNN_HEAD_DIM ** -0.5),
        "b_i": nrm(ks[21], (L, 2, D_RNN), 0.02),
        "lam": jnp.log(a0 / (1.0 - a0)),
        "gmlp_norm": gain(ks[22], (L, D_GMLP)),
        "w_s": nrm(ks[23], (L, GMLP_GROUPS, CHUNK, CHUNK), CHUNK ** -0.5),
        "b_s": gain(ks[24], (L, GMLP_GROUPS, CHUNK)),
        "w_br": nrm(ks[25], (L, D_RNN, D_MODEL), D_RNN ** -0.5),
        "w_bg": nrm(ks[26], (L, D_GMLP, D_MODEL), D_GMLP ** -0.5),
        "w_out": nrm(ks[27], (L, D_MODEL, D_MODEL), D_MODEL ** -0.5),
        "ff2_gate": nrm(ks[28], (L, D_MODEL, D_FF), D_MODEL ** -0.5),
        "ff2_up": nrm(ks[29], (L, D_MODEL, D_FF), D_MODEL ** -0.5),
        "ff2_down": nrm(ks[30], (L, D_FF, D_MODEL), D_FF ** -0.5),
        "norm_f": gain(ks[31], (D_MODEL,)),
    }


def reference(x_prompt, x_sample, state_rnn_fwd, state_rnn_bwd, c, c_ctx,
              w_mod, b_mod, norm1, norm2, norm3, ff1_gate, ff1_up, ff1_down,
              w_in, conv_w, conv_b, w_r, b_r, w_i, b_i, lam, gmlp_norm, w_s, b_s,
              w_br, w_bg, w_out, ff2_gate, ff2_up, ff2_down, norm_f):
    def layer_params(l):
        return dict(w_mod=w_mod[l], b_mod=b_mod[l], norm1=norm1[l], norm2=norm2[l], norm3=norm3[l],
                    ff1_gate=ff1_gate[l], ff1_up=ff1_up[l], ff1_down=ff1_down[l],
                    w_in=w_in[l], conv_w=conv_w[l], conv_b=conv_b[l],
                    w_r=w_r[l], b_r=b_r[l], w_i=w_i[l], b_i=b_i[l], lam=lam[l],
                    gmlp_norm=gmlp_norm[l], w_s=w_s[l], b_s=b_s[l],
                    w_br=w_br[l], w_bg=w_bg[l], w_out=w_out[l],
                    ff2_gate=ff2_gate[l], ff2_up=ff2_up[l], ff2_down=ff2_down[l])

    xc = x_prompt
    zeros = jnp.zeros((x_prompt.shape[0], D_RNN), x_prompt.dtype)
    st_f, st_b = [], []
    for l in range(DEPTH):
        xc, hf, hb = trunk_layer(xc, c_ctx[None], zeros, zeros, layer_params(l))
        st_f.append(hf)
        st_b.append(hb)
    y_prompt = rms_norm(xc, norm_f)
    new_state_rnn_fwd = jnp.stack(st_f, axis=1)
    new_state_rnn_bwd = jnp.stack(st_b, axis=1)

    xs = x_sample + grid_pos_embed(x_sample.shape[1], x_sample.dtype)[None]
    for l in range(DEPTH):
        xs, _, _ = trunk_layer(xs, c, state_rnn_fwd[:, l], state_rnn_bwd[:, l], layer_params(l))
    y_sample = rms_norm(xs, norm_f)

    return (y_prompt, y_sample, new_state_rnn_fwd, new_state_rnn_bwd)
```

```cpp
#include <hip/hip_runtime.h>
#include <hip/hip_cooperative_groups.h>
#include <cstdio>
#include <type_traits>
namespace cg = cooperative_groups;

#ifndef EPI_REP
#define EPI_REP 1
#endif
#ifndef PROBE_SYNCS
#define PROBE_SYNCS 0
#endif
#ifndef PROBE_PH
#define PROBE_PH (-1)
#define PROBE_REP 1
#endif
#ifndef ONE_LAUNCH
#define ONE_LAUNCH 1
#endif

#define LAS __attribute__((address_space(3)))
typedef unsigned short bf16_t;
typedef short bf16x8 __attribute__((ext_vector_type(8)));
typedef float f32x4 __attribute__((ext_vector_type(4)));
typedef float f32x16 __attribute__((ext_vector_type(16)));
typedef unsigned u32x4 __attribute__((ext_vector_type(4)));
typedef unsigned u32x2 __attribute__((ext_vector_type(2)));

constexpr int MTOK = 40960, MCTX = 8192, DM = 1024, DFF = 2816, NMODC = 9216;
constexpr int NSC = 320;
constexpr size_t OUT_SF = (size_t)MTOK * DM, OUT_SB = OUT_SF + 32 * 1024;
constexpr int LDS_BYTES = 131072 + 64;
constexpr int NPH = 16;

constexpr size_t WS_FF1 = 0;
constexpr size_t WS_FF1D = WS_FF1 + (size_t)5632 * 1024 * 2;
constexpr size_t WS_FF2 = WS_FF1D + (size_t)1024 * 2816 * 2;
constexpr size_t WS_FF2D = WS_FF2 + (size_t)5632 * 1024 * 2;
constexpr size_t WS_IN = WS_FF2D + (size_t)1024 * 2816 * 2;
constexpr size_t WS_CAT = WS_IN + (size_t)6144 * 1024 * 2;
constexpr size_t WS_OUT = WS_CAT + (size_t)1024 * 2048 * 2;
constexpr size_t WS_WG = WS_OUT + (size_t)1024 * 1024 * 2;
constexpr size_t WS_WS = WS_WG + (size_t)2 * 2 * 16 * 4096 * 2;
constexpr size_t WS_PE = WS_WS + (size_t)8 * 128 * 128 * 2;
constexpr size_t WS_MOD = WS_PE + (size_t)64 * 512 * 4;
constexpr size_t WS_VSS = WS_MOD + (size_t)9 * 9216 * 4;
constexpr size_t WS_SUMA = WS_VSS + (size_t)MTOK * 16 * 4;
constexpr size_t WS_SUMB = WS_SUMA + (size_t)2 * NSC * 1024 * 4;
constexpr size_t WS_HMOD = WS_SUMB + (size_t)2 * NSC * 1024 * 4;
constexpr size_t WS_Z = WS_HMOD + (size_t)MTOK * 1024 * 2;
constexpr size_t WS_BAR = WS_Z + (size_t)MTOK * 4096 * 2;
constexpr size_t WS_END = WS_BAR + 16384;
constexpr size_t WS_D2 = WS_Z + ((size_t)240 << 20);
constexpr int SPLIT_ROW0 = 32768;
constexpr size_t WS_PTAB = WS_BAR + 15360;

struct Params {
    const float* x_prompt; const float* x_sample; const float* st_f; const float* st_b; const float* c; const float* c_ctx;
    const float* w_mod; const float* b_mod; const float* norm1; const float* norm2; const float* norm3;
    const float* ff1_gate; const float* ff1_up; const float* ff1_down; const float* w_in; const float* conv_w; const float* conv_b;
    const float* w_r; const float* b_r; const float* w_i; const float* b_i; const float* lam; const float* gmlp_norm; const float* w_s; const float* b_s;
    const float* w_br; const float* w_bg; const float* w_out; const float* ff2_gate; const float* ff2_up; const float* ff2_down; const float* norm_f;
    float* out; unsigned char* ws; int ph_lo, ph_hi;
};

__device__ __forceinline__ float bf2f(unsigned b) { return __uint_as_float(b << 16); }
__device__ __forceinline__ float bflo(unsigned w) { return __uint_as_float(w << 16); }
__device__ __forceinline__ float bfhi(unsigned w) { return __uint_as_float(w & 0xffff0000u); }
typedef float f32x2 __attribute__((ext_vector_type(2)));
typedef __bf16 bf16x2_t __attribute__((ext_vector_type(2)));
__device__ __forceinline__ unsigned cvt_pk_bf16(float lo, float hi) { const f32x2 v = {lo, hi}; return __builtin_bit_cast(unsigned, __builtin_convertvector(v, bf16x2_t)); }
__device__ __forceinline__ bf16_t f2bf(float f) { return (bf16_t)(cvt_pk_bf16(f, 0.f) & 0xffffu); }
__device__ __forceinline__ float sigm(float x) { return __builtin_amdgcn_rcpf(1.0f + __builtin_amdgcn_exp2f(-1.4426950408889634f * x)); }
__device__ __forceinline__ float gelu_t(float x) { const float y2 = x * (-2.302208198f - 0.1029432397f * x * x); return x * __builtin_amdgcn_rcpf(1.0f + __builtin_amdgcn_exp2f(y2)); }
__device__ __forceinline__ int modrow_of(int row) { return row < MCTX ? 8 : ((row - MCTX) >> 12); }

namespace pg8 {
constexpr int BM = 256, BK = 64, HALF = 128, HTB = HALF * BK * 2, STAGE_BYTES = 8 * HTB, NXCD = 8, WGM = 8;
__host__ __device__ __forceinline__ int lds_byte(int r, int c) { const int st = (r >> 4) * 2 + (c >> 5), rr = r & 15, cc = c & 31, ob = rr * 64 + cc * 2; return st * 1024 + (ob ^ (((ob >> 9) & 1) << 5)); }
__host__ __device__ __forceinline__ void stage_rc(int b, int& R, int& C) { const int st = b / 1024, sb = b % 1024, swz = sb ^ (((sb >> 9) & 1) << 5); R = (st >> 1) * 16 + swz / 64; C = (st & 1) * 32 + (swz % 64) / 2; }
__host__ __device__ __forceinline__ int perm32(int rho) { const int n = rho >> 4, i = rho & 15; return 8 * (i >> 2) + 4 * n + (i & 3); }
struct Unit { int pm, pn, k0, nt, part; };
struct Gemm { const bf16_t* A; int lda; const bf16_t* Bt; int M, N, K; };
struct StaticOrder {
    int nM, nN, nwg, G, c, ntk;
    __device__ __forceinline__ void init(int M, int N, int G_, int c_, int ntk_) { nM = M / BM; nN = N / BM; nwg = nM * nN; G = G_; c = c_; ntk = ntk_; }
    __device__ __forceinline__ Unit next(int i) const {
        Unit u; u.pm = -1; u.pn = 0; u.k0 = 0; u.nt = ntk; u.part = 0;
        const long L = (long)i * G + c; if (L >= nwg) return u;
        int wgid = (int)L; { const int q = nwg / NXCD, r = nwg % NXCD, xcd = wgid % NXCD, off = wgid / NXCD; wgid = (xcd < r ? xcd * (q + 1) : r * (q + 1) + (xcd - r) * q) + off; }
        const int nig = WGM * nN, gid = wgid / nig, fm = gid * WGM, gsz = (nM - fm) < WGM ? (nM - fm) : WGM;
        u.pm = fm + ((wgid % nig) % gsz); u.pn = (wgid % nig) / gsz; return u;
    }
};
struct BalancedOrder {
    StaticOrder so; bool bal; int c;
    __device__ __forceinline__ void init(int M, int N, int G_, int c_, int ntk_) { so.init(M, N, G_, c_, ntk_); c = c_; bal = (G_ == 256 && M == 40960 && N == 1024 && (ntk_ & 3) == 0); }
    __device__ __forceinline__ Unit next(int i) const {
        if (!bal) return so.next(i);
        const int xcd = c & 7, r = c >> 3, tile = r >> 1, half = so.ntk >> 1;
        Unit u;
        u.pm = i < 2 ? (i * 8 + xcd) * 8 + (r >> 2) : (i == 2 ? 128 + xcd * 4 + (tile >> 2) : -1);
        u.pn = i < 2 ? (r & 3) : (tile & 3);
        u.part = i < 2 ? 0 : (r & 1);
        u.nt = i < 2 ? so.ntk : half;
        u.k0 = i < 2 ? 0 : (r & 1) * half;
        return u;
    }
};

template <class Epi, class Sched>
__device__ __forceinline__ void gemm_phase(LAS unsigned char* lds, const Gemm g, const Sched& S, const Epi& E, const int tid) {
    const int wid = __builtin_amdgcn_readfirstlane(tid >> 6), lane = tid & 63, wr = wid >> 2, wc = wid & 3, fr = lane & 15, fq = lane >> 4;
    const int K = g.K, lda = g.lda;
    unsigned voffA[2], voffB[2], voffA1[2], voffB1[2];
#pragma unroll
    for (int i = 0; i < 2; ++i) { int R, C; stage_rc(tid * 16 + i * 8192, R, C); const int Rb = Epi::PERM ? ((R & ~31) + perm32(R & 31)) : R;
        voffA[i] = (unsigned)(R * lda + C) * 2u; voffB[i] = (unsigned)(Rb * K + C) * 2u; }
#pragma unroll
    for (int i = 0; i < 2; ++i) { voffA1[i] = voffA[i] + (unsigned)(HALF * lda * 2); voffB1[i] = voffB[i] + (unsigned)(HALF * K * 2); }
    const size_t kstep = (size_t)(BK * 2);
    const size_t hstepA = (size_t)HALF * lda * 2, hstepB = (size_t)HALF * K * 2;
    const size_t tstepA = 2 * hstepA, tstepB = 2 * hstepB;
    const unsigned ldsw = (unsigned)wid * 1024u;
    const int aoff = lds_byte(wr * 64 + fr, fq * 8), boff = lds_byte(wc * 32 + fr, fq * 8);
#define PG8_SA(b, h) (((b) * 2 + (h)) * HTB)
#define PG8_SB(b, h) ((4 + (b) * 2 + (h)) * HTB)
#define PG8_STAGE(bufoff, gbase, voff) do { _Pragma("unroll") for (int _i = 0; _i < 2; ++_i) { \
        const int _m0 = __builtin_amdgcn_readfirstlane((int)(unsigned long)(lds + (bufoff) + ldsw + _i * 8192));     \
        asm volatile("s_mov_b32 m0, %2\n\tglobal_load_lds_dwordx4 %0, %1" :: "v"((voff)[_i]), "s"((const char*)(gbase)), "s"(_m0) : "memory", "m0"); } } while (0)
#define PG8_LDA(dst, b, h) do { _Pragma("unroll") for (int m = 0; m < 4; ++m) _Pragma("unroll") for (int k = 0; k < 2; ++k) dst[m][k] = *(const LAS bf16x8*)(lds + PG8_SA(b, h) + aoff + m * 2048 + k * 1024); } while (0)
#define PG8_LDB(dst, b, h) do { _Pragma("unroll") for (int n = 0; n < 2; ++n) _Pragma("unroll") for (int k = 0; k < 2; ++k) dst[n][k] = *(const LAS bf16x8*)(lds + PG8_SB(b, h) + boff + n * 2048 + k * 1024); } while (0)
#define PG8_MMA(ai, bj, At, Bt) do { __builtin_amdgcn_s_setprio(1); _Pragma("unroll") for (int m = 0; m < 4; ++m) _Pragma("unroll") for (int n = 0; n < 2; ++n) _Pragma("unroll") for (int k = 0; k < 2; ++k) \
        acc[ai][bj][m][n] = __builtin_amdgcn_mfma_f32_16x16x32_bf16(Bt[n][k], At[m][k], acc[ai][bj][m][n], 0, 0, 0); __builtin_amdgcn_s_setprio(0); } while (0)
#define PG8_WAIT_V(n) asm volatile("s_waitcnt vmcnt(" #n ")" ::: "memory")
#define PG8_WAIT_L(n) asm volatile("s_waitcnt lgkmcnt(" #n ")" ::: "memory")
#define PG8_BAR __builtin_amdgcn_s_barrier()
#define PG8_SCHED __builtin_amdgcn_sched_barrier(0)
    Unit cur = S.next(0), nxt; int ui = 0;
    if (cur.pm < 0) return;
    f32x4 acc[2][2][4][2];
#pragma unroll
    for (int a = 0; a < 2; ++a)
#pragma unroll
        for (int b = 0; b < 2; ++b)
#pragma unroll
            for (int m = 0; m < 4; ++m)
#pragma unroll
                for (int n = 0; n < 2; ++n) acc[a][b][m][n] = (f32x4){0.f, 0.f, 0.f, 0.f};
    bf16x8 At[4][2], B0[2][2], B1[2][2];
    const char* cA = (const char*)g.A + (size_t)cur.pm * tstepA + (size_t)cur.k0 * kstep; const char* cB = (const char*)g.Bt + (size_t)cur.pn * tstepB + (size_t)cur.k0 * kstep;
    PG8_STAGE(PG8_SB(0, 0), cB, voffB); PG8_STAGE(PG8_SA(0, 0), cA, voffA); PG8_STAGE(PG8_SB(0, 1), cB, voffB1); PG8_STAGE(PG8_SA(0, 1), cA, voffA1);
    if (wr == 1) PG8_BAR;
    PG8_WAIT_V(4); PG8_BAR;
    PG8_STAGE(PG8_SB(1, 0), cB + kstep, voffB); PG8_STAGE(PG8_SA(1, 0), cA + kstep, voffA); PG8_STAGE(PG8_SB(1, 1), cB + kstep, voffB1);
    PG8_WAIT_V(6); PG8_BAR;
    for (;;) {
        nxt = S.next(ui + 1);
        const bool has_next = nxt.pm >= 0;
        const char* nA = has_next ? (const char*)g.A + (size_t)nxt.pm * tstepA + (size_t)nxt.k0 * kstep : cA; const char* nB = has_next ? (const char*)g.Bt + (size_t)nxt.pn * tstepB + (size_t)nxt.k0 * kstep : cB;
        const int nt = cur.nt;
        for (int t = 0; t < nt; t += 2) {
            const bool last = (t == nt - 2);
            const char* a1 = cA + (size_t)(t + 1) * kstep;
            const char* a2 = last ? nA : cA + (size_t)(t + 2) * kstep; const char* b2 = last ? nB : cB + (size_t)(t + 2) * kstep;
            const char* a3 = a2 + kstep; const char* b3 = b2 + kstep;
            if constexpr (Epi::HAS_MID) { if (t == (nt >> 1)) { int fr2 = fr, fq2 = fq; asm volatile("" : "+v"(fr2), "+v"(fq2)); E.mid(acc, cur, wr, wc, fr2, fq2); } }
            PG8_LDB(B0, 0, 0); PG8_SCHED; PG8_LDA(At, 0, 0); PG8_STAGE(PG8_SA(1, 1), a1, voffA1);
            PG8_WAIT_L(8); PG8_BAR; PG8_MMA(0, 0, At, B0); PG8_BAR; PG8_SCHED;
            PG8_LDB(B1, 0, 1); PG8_STAGE(PG8_SB(0, 0), b2, voffB);
            PG8_WAIT_V(10); PG8_BAR; PG8_MMA(0, 1, At, B1); PG8_BAR;
            PG8_LDA(At, 0, 1); PG8_STAGE(PG8_SA(0, 0), a2, voffA);
            PG8_BAR; PG8_MMA(1, 0, At, B0); PG8_BAR; PG8_SCHED;
            PG8_STAGE(PG8_SB(0, 1), b2, voffB1);
            PG8_WAIT_V(8); PG8_BAR; PG8_MMA(1, 1, At, B1); PG8_BAR;
            PG8_LDB(B0, 1, 0); PG8_SCHED; PG8_LDA(At, 1, 0); PG8_STAGE(PG8_SA(0, 1), a2, voffA1);
            PG8_WAIT_L(8); PG8_BAR; PG8_MMA(0, 0, At, B0); PG8_BAR; PG8_SCHED;
            PG8_LDB(B1, 1, 1); PG8_STAGE(PG8_SB(1, 0), b3, voffB);
            PG8_WAIT_V(10); PG8_BAR; PG8_MMA(0, 1, At, B1); PG8_BAR;
            PG8_LDA(At, 1, 1); PG8_STAGE(PG8_SA(1, 0), a3, voffA);
            PG8_BAR; PG8_MMA(1, 0, At, B0); PG8_BAR; PG8_SCHED;
            PG8_STAGE(PG8_SB(1, 1), b3, voffB1);
            PG8_WAIT_V(8); PG8_BAR; PG8_MMA(1, 1, At, B1); PG8_BAR;
        }
        for (int er = 0; er < (Epi::HAS_MID ? 1 : EPI_REP); ++er) { int fr2 = fr, fq2 = fq; asm volatile("" : "+v"(fr2), "+v"(fq2)); E(acc, cur, wr, wc, fr2, fq2); }
        if (!has_next) break;
#pragma unroll
        for (int a = 0; a < 2; ++a)
#pragma unroll
            for (int b = 0; b < 2; ++b)
#pragma unroll
                for (int m = 0; m < 4; ++m)
#pragma unroll
                    for (int n = 0; n < 2; ++n) acc[a][b][m][n] = (f32x4){0.f, 0.f, 0.f, 0.f};
        cur = nxt; cA = nA; cB = nB; ++ui;
    }
    PG8_WAIT_V(0);
    if (wr == 0) PG8_BAR;
    PG8_BAR;
#undef PG8_SA
#undef PG8_SB
#undef PG8_STAGE
#undef PG8_LDA
#undef PG8_LDB
#undef PG8_MMA
#undef PG8_WAIT_V
#undef PG8_WAIT_L
#undef PG8_BAR
#undef PG8_SCHED
}
}
using pg8::Unit;
typedef f32x4 AccT[2][2][4][2];

struct EpiSwiGLU {
    static constexpr bool PERM = true, HAS_MID = false;
    bf16_t* H;
    __device__ __forceinline__ void operator()(const AccT& acc, const Unit& u, int wr, int wc, int fr, int fq) const {
        const int row0 = u.pm * 256 + wr * 64 + fr, col0 = u.pn * 128 + wc * 32 + 8 * fq;
#pragma unroll
        for (int ai = 0; ai < 2; ++ai)
#pragma unroll
            for (int m = 0; m < 4; ++m) {
                bf16_t* rowp = H + (size_t)(row0 + ai * 128 + m * 16) * DFF + col0;
                float h[8];
#pragma unroll
                for (int n = 0; n < 2; ++n)
#pragma unroll
                    for (int j = 0; j < 4; ++j) { const float gt = acc[ai][0][m][n][j], up = acc[ai][1][m][n][j]; h[n * 4 + j] = gt * sigm(gt) * up; }
                u32x4 w; w.x = cvt_pk_bf16(h[0], h[1]); w.y = cvt_pk_bf16(h[2], h[3]); w.z = cvt_pk_bf16(h[4], h[5]); w.w = cvt_pk_bf16(h[6], h[7]);
                *(u32x4*)rowp = w;
            }
    }
};
template <bool ACC>
struct EpiDelta {
    static constexpr bool PERM = true, HAS_MID = false;
    bf16_t* D; const bf16_t* Din; const float* modg; float scale; bf16_t* D2;
    __device__ __forceinline__ void operator()(const AccT& acc, const Unit& u, int wr, int wc, int fr, int fq) const {
        const int row0 = u.pm * 256 + wr * 64 + fr, col0 = u.pn * 256 + wc * 32 + 8 * fq;
        const bool side = u.part != 0;
        const long long dofs = side ? (long long)(D2 - D) : 0ll;
        const float* gp = modg + (size_t)modrow_of(u.pm * 256) * NMODC + col0;
        f32x4 gv[2][2];
#pragma unroll
        for (int bj = 0; bj < 2; ++bj)
#pragma unroll
            for (int n = 0; n < 2; ++n) gv[bj][n] = *(const f32x4*)(gp + bj * 128 + n * 4) * scale;
#pragma unroll
        for (int ai = 0; ai < 2; ++ai) {
            u32x4 q[4][2];
            if (ACC && !side) {
#pragma unroll
                for (int m = 0; m < 4; ++m)
#pragma unroll
                    for (int bj = 0; bj < 2; ++bj) q[m][bj] = *(const u32x4*)(Din + (size_t)(row0 + ai * 128 + m * 16) * DM + col0 + bj * 128);
            }
#pragma unroll
            for (int m = 0; m < 4; ++m) {
                bf16_t* rowp = D + dofs + (size_t)(row0 + ai * 128 + m * 16) * DM + col0;
#pragma unroll
                for (int bj = 0; bj < 2; ++bj) { f32x4 v0 = acc[ai][bj][m][0] * gv[bj][0], v1 = acc[ai][bj][m][1] * gv[bj][1];
                    if (ACC && !side) { const u32x4 g = q[m][bj]; v0 += (f32x4){bflo(g.x), bfhi(g.x), bflo(g.y), bfhi(g.y)}; v1 += (f32x4){bflo(g.z), bfhi(g.z), bflo(g.w), bfhi(g.w)}; }
                    u32x4 w; w.x = cvt_pk_bf16(v0[0], v0[1]); w.y = cvt_pk_bf16(v0[2], v0[3]); w.z = cvt_pk_bf16(v1[0], v1[1]); w.w = cvt_pk_bf16(v1[2], v1[3]);
                    *(u32x4*)(rowp + bj * 128) = w; }
            }
        }
    }
};
struct EpiZ {
    static constexpr bool PERM = true, HAS_MID = false;
    bf16_t* Z; float* VSS;
    __device__ __forceinline__ void operator()(const AccT& acc, const Unit& u, int wr, int wc, int fr, int fq) const {
        const int sec = u.pn >> 2;
        const int row0 = u.pm * 256 + wr * 64 + fr, col0 = u.pn * 256 + wc * 32 + 8 * fq;
#pragma unroll
        for (int ai = 0; ai < 2; ++ai)
#pragma unroll
            for (int m = 0; m < 4; ++m) {
                const int row = row0 + ai * 128 + m * 16;
                bf16_t* rowp = Z + (size_t)row * 4096 + col0;
                float ss = 0.f;
#pragma unroll
                for (int bj = 0; bj < 2; ++bj) {
                    float v[8];
#pragma unroll
                    for (int n = 0; n < 2; ++n)
#pragma unroll
                        for (int j = 0; j < 4; ++j) { float x = acc[ai][bj][m][n][j]; if (sec) x = gelu_t(x); v[n * 4 + j] = x; ss += x * x; }
                    u32x4 w; w.x = cvt_pk_bf16(v[0], v[1]); w.y = cvt_pk_bf16(v[2], v[3]); w.z = cvt_pk_bf16(v[4], v[5]); w.w = cvt_pk_bf16(v[6], v[7]);
                    *(u32x4*)(rowp + bj * 128) = w;
                }
                if (sec == 3) { ss += __shfl_xor(ss, 16); ss += __shfl_xor(ss, 32); if (fq == 0) VSS[(size_t)row * 16 + (u.pn - 12) * 4 + wc] = ss; }
            }
    }
};
struct EpiGates {
    static constexpr bool PERM = true, HAS_MID = false;
    bf16_t* Z;
    __device__ __forceinline__ void operator()(const AccT& acc, const Unit& u, int wr, int wc, int fr, int fq) const {
        const int row0 = u.pm * 256 + wr * 64 + fr, col0 = u.pn * 128 + wc * 32 + 8 * fq;
#pragma unroll
        for (int ai = 0; ai < 2; ++ai)
#pragma unroll
            for (int m = 0; m < 4; ++m) {
                bf16_t* rowp = Z + (size_t)(row0 + ai * 128 + m * 16) * 4096 + col0;
                float rt[8], sb[8];
#pragma unroll
                for (int n = 0; n < 2; ++n)
#pragma unroll
                    for (int j = 0; j < 4; ++j) {
                        const float ea = __builtin_amdgcn_exp2f(__builtin_amdgcn_fmed3f(-1.4426950408889634f * acc[ai][0][m][n][j], -3.0e38f, 80.f));
                        const float eb = __builtin_amdgcn_exp2f(__builtin_amdgcn_fmed3f(-1.4426950408889634f * acc[ai][1][m][n][j], -3.0e38f, 80.f));
                        rt[n * 4 + j] = (1.0f + eb) * __builtin_amdgcn_rcpf(1.0f + ea); sb[n * 4 + j] = __builtin_amdgcn_rcpf(1.0f + eb); }
                u32x4 w; w.x = cvt_pk_bf16(rt[0], rt[1]); w.y = cvt_pk_bf16(rt[2], rt[3]); w.z = cvt_pk_bf16(rt[4], rt[5]); w.w = cvt_pk_bf16(rt[6], rt[7]);
                *(u32x4*)rowp = w;
                w.x = cvt_pk_bf16(sb[0], sb[1]); w.y = cvt_pk_bf16(sb[2], sb[3]); w.z = cvt_pk_bf16(sb[4], sb[5]); w.w = cvt_pk_bf16(sb[6], sb[7]);
                *(u32x4*)(rowp + 3072) = w;
            }
    }
};
struct EpiMerge {
    static constexpr bool PERM = true, HAS_MID = true;
    const bf16_t* Z; bf16_t* O;
    __device__ __forceinline__ void scale(AccT& acc, const Unit& u, int wr, int wc, int fr, int fq, int zoff) const {
        const int row0 = u.pm * 256 + wr * 64 + fr, col0 = u.pn * 256 + wc * 32 + 8 * fq;
        u32x4 q[2][4][2];
#pragma unroll
        for (int ai = 0; ai < 2; ++ai)
#pragma unroll
            for (int m = 0; m < 4; ++m)
#pragma unroll
                for (int bj = 0; bj < 2; ++bj) q[ai][m][bj] = *(const u32x4*)(Z + (size_t)(row0 + ai * 128 + m * 16) * 4096 + zoff + col0 + bj * 128);
#pragma unroll
        for (int ai = 0; ai < 2; ++ai)
#pragma unroll
            for (int m = 0; m < 4; ++m)
#pragma unroll
                for (int bj = 0; bj < 2; ++bj) { const u32x4 g = q[ai][m][bj];
                    acc[ai][bj][m][0] *= (f32x4){bflo(g.x), bfhi(g.x), bflo(g.y), bfhi(g.y)};
                    acc[ai][bj][m][1] *= (f32x4){bflo(g.z), bfhi(g.z), bflo(g.w), bfhi(g.w)}; }
    }
    __device__ __forceinline__ void mid(AccT& acc, const Unit& u, int wr, int wc, int fr, int fq) const { scale(acc, u, wr, wc, fr, fq, 0); }
    __device__ __forceinline__ void operator()(AccT& acc, const Unit& u, int wr, int wc, int fr, int fq) const {
        scale(acc, u, wr, wc, fr, fq, 3072);
        const int row0 = u.pm * 256 + wr * 64 + fr, col0 = u.pn * 256 + wc * 32 + 8 * fq;
#pragma unroll
        for (int ai = 0; ai < 2; ++ai)
#pragma unroll
            for (int m = 0; m < 4; ++m) {
                bf16_t* op = O + (size_t)(row0 + ai * 128 + m * 16) * DM + col0;
#pragma unroll
                for (int bj = 0; bj < 2; ++bj) { const f32x4 v0 = acc[ai][bj][m][0], v1 = acc[ai][bj][m][1];
                    u32x4 w; w.x = cvt_pk_bf16(v0[0], v0[1]); w.y = cvt_pk_bf16(v0[2], v0[3]); w.z = cvt_pk_bf16(v1[0], v1[1]); w.w = cvt_pk_bf16(v1[2], v1[3]);
                    *(u32x4*)(op + bj * 128) = w; }
            }
    }
};

__device__ __forceinline__ void transpose_tile(const float* __restrict__ src, int ldsrc, int k0, int n0, bf16_t* dst, int lddst, int drow0, int dcol0, float* tile, const int tid) {
#pragma unroll
    for (int i = 0; i < 2; ++i) { const int e = tid + i * 512, kr = e >> 4, c4 = (e & 15) * 4;
        const f32x4 v = *(const f32x4*)(src + (size_t)(k0 + kr) * ldsrc + n0 + c4);
        float* tp = tile + kr * 65 + c4; tp[0] = v[0]; tp[1] = v[1]; tp[2] = v[2]; tp[3] = v[3]; }
    __syncthreads();
    const int nr = tid >> 3, kg = (tid & 7) * 8;
    float v[8];
#pragma unroll
    for (int j = 0; j < 8; ++j) v[j] = tile[(kg + j) * 65 + nr];
    u32x4 w; w.x = cvt_pk_bf16(v[0], v[1]); w.y = cvt_pk_bf16(v[2], v[3]); w.z = cvt_pk_bf16(v[4], v[5]); w.w = cvt_pk_bf16(v[6], v[7]);
    *(u32x4*)(dst + (size_t)(drow0 + nr) * lddst + dcol0 + kg) = w;
    __syncthreads();
}

__device__ __forceinline__ void transpose_range(unsigned char* wsb, unsigned char* shm, const int tid, const int wg, const int nwg, const int nv, const int mode) {
    const float* const* pt = (const float* const*)(wsb + WS_PTAB);
    auto vmap = [&](int v) { return mode == 0 ? (v < 2112 ? v : v + 2112) : (mode == 1 ? 1408 + v : (mode == 2 ? 2112 + v : v)); };
    float* tile = (float*)shm;
    const int G = nwg; const int bid = wg;
    struct TJob { const float* src; bf16_t* dst; int ldsrc, lddst; };
    auto job_of = [&](int ti, TJob& j) {
        int k0, n0, drow, dcol;
        if (ti < 4224) {
            const int f = ti / 2112, r = ti % 2112, kind = r / 704, tt = r % 704;
            if (kind < 2) { const int kt = tt / 44, ntile = tt % 44; n0 = ntile * 64; k0 = kt * 64;
                j.src = pt[f * 3 + kind]; j.ldsrc = DFF;
                j.dst = (bf16_t*)(wsb + (f ? WS_FF2 : WS_FF1)); j.lddst = 1024; drow = 256 * (n0 >> 7) + (n0 & 127) + (kind ? 128 : 0); dcol = k0;
            } else { const int kt = tt / 16, ntile = tt % 16; n0 = ntile * 64; k0 = kt * 64;
                j.src = pt[f * 3 + 2]; j.ldsrc = 1024; j.dst = (bf16_t*)(wsb + (f ? WS_FF2D : WS_FF1D)); j.lddst = DFF; drow = n0; dcol = k0; }
        } else if (ti < 5760) { const int tt = ti - 4224, kt = tt / 96, ntile = tt % 96; n0 = ntile * 64; k0 = kt * 64;
            const int cc = (n0 - 4096) & 1023;
            j.src = pt[6]; j.ldsrc = 6144; j.dst = (bf16_t*)(wsb + WS_IN); j.lddst = 1024; dcol = k0;
            drow = n0 < 4096 ? n0 : 4096 + 256 * (cc >> 7) + (cc & 127) + (n0 >= 5120 ? 128 : 0);
        } else { const int tt = ti - 5760, which = tt >> 8, r = tt & 255, kt = r >> 4, ntile = r & 15; n0 = ntile * 64; k0 = kt * 64;
            j.src = pt[7 + which]; j.ldsrc = 1024; drow = n0;
            if (which < 2) { j.dst = (bf16_t*)(wsb + WS_CAT); j.lddst = 2048; dcol = which * 1024 + k0; } else { j.dst = (bf16_t*)(wsb + WS_OUT); j.lddst = 1024; dcol = k0; }
        }
        j.src += (size_t)k0 * j.ldsrc + n0; j.dst += (size_t)drow * j.lddst + dcol;
    };
    {
        TJob cur[2], nxt[2]; f32x4 ld[2][2];
        float* tile2 = tile + 64 * 65;
        int ti = bid * 2;
        auto issue = [&](int t0, TJob (&jb)[2]) {
#pragma unroll
            for (int h = 0; h < 2; ++h) if (t0 + h < nv) { job_of(vmap(t0 + h), jb[h]);
#pragma unroll
                for (int i = 0; i < 2; ++i) { const int e = tid + i * 512; ld[h][i] = *(const f32x4*)(jb[h].src + (size_t)(e >> 4) * jb[h].ldsrc + (e & 15) * 4); } }
        };
        if (ti < nv) issue(ti, cur);
        for (; ti < nv; ti += 2 * G) {
#pragma unroll
            for (int h = 0; h < 2; ++h) if (ti + h < nv) {
#pragma unroll
                for (int i = 0; i < 2; ++i) { const int e = tid + i * 512; float* tp = (h ? tile2 : tile) + (e >> 4) * 65 + (e & 15) * 4; tp[0] = ld[h][i][0]; tp[1] = ld[h][i][1]; tp[2] = ld[h][i][2]; tp[3] = ld[h][i][3]; } }
            __syncthreads();
            const bool more = ti + 2 * G < nv;
            if (more) issue(ti + 2 * G, nxt);
            const int nr = tid >> 3, kg = (tid & 7) * 8;
#pragma unroll
            for (int h = 0; h < 2; ++h) if (ti + h < nv) {
                const float* tb = h ? tile2 : tile;
                float v[8];
#pragma unroll
                for (int jj = 0; jj < 8; ++jj) v[jj] = tb[(kg + jj) * 65 + nr];
                u32x4 w; w.x = cvt_pk_bf16(v[0], v[1]); w.y = cvt_pk_bf16(v[2], v[3]); w.z = cvt_pk_bf16(v[4], v[5]); w.w = cvt_pk_bf16(v[6], v[7]);
                *(u32x4*)(cur[h].dst + (size_t)nr * cur[h].lddst + kg) = w; }
            __syncthreads();
            if (more) { cur[0] = nxt[0]; cur[1] = nxt[1]; }
        }
    }
}

__device__ __forceinline__ void prep_phase(const Params& p, unsigned char* shm, const int tid, const int bid) {
    const int G = gridDim.x;
    for (int item = bid; item < 144; item += G) {
        float* scond = (float*)shm; float* red = (float*)(shm + 36864);
        for (int e = tid; e < 9216; e += 512) { const int b = e >> 10, k = e & 1023; const float cv = b < 8 ? p.c[b * 1024 + k] : p.c_ctx[k]; scond[e] = cv / (1.0f + __expf(-cv)); }
        __syncthreads();
        const int n0 = item * 64, cl = tid & 63, kg = tid >> 6;
        float acc[9];
#pragma unroll
        for (int b = 0; b < 9; ++b) acc[b] = 0.f;
        const float* wp = p.w_mod + (size_t)(kg * 128) * NMODC + n0 + cl;
#pragma unroll 16
        for (int k = 0; k < 128; ++k) { const float wv = wp[(size_t)k * NMODC];
#pragma unroll
            for (int b = 0; b < 9; ++b) acc[b] += scond[b * 1024 + kg * 128 + k] * wv; }
#pragma unroll
        for (int b = 0; b < 9; ++b) red[(kg * 9 + b) * 64 + cl] = acc[b];
        __syncthreads();
        float* MOD = (float*)(p.ws + WS_MOD);
        for (int e = tid; e < 576; e += 512) { const int b = e >> 6, cc = e & 63; float s = p.b_mod[n0 + cc];
#pragma unroll
            for (int k2 = 0; k2 < 8; ++k2) s += red[(k2 * 9 + b) * 64 + cc];
            MOD[b * NMODC + n0 + cc] = s; }
        __syncthreads();
    }
    if (tid == 0) { const float** ptw = (const float**)(p.ws + WS_PTAB);
        ptw[0] = p.ff1_gate; ptw[1] = p.ff1_up; ptw[2] = p.ff1_down; ptw[3] = p.ff2_gate; ptw[4] = p.ff2_up; ptw[5] = p.ff2_down; ptw[6] = p.w_in; ptw[7] = p.w_br; ptw[8] = p.w_bg; ptw[9] = p.w_out; }
    __syncthreads();
    if (G == 256) transpose_range(p.ws, shm, tid, bid, G, 4416, 0); else transpose_range(p.ws, shm, tid, bid, G, 6528, 3);
    const int gt = bid * 512 + tid, GT = G * 512;
    for (int idx = gt; idx < 32768; idx += GT) {
        const int lane = idx & 63, ks = (idx >> 6) & 3, cb = (idx >> 8) & 1, head = (idx >> 9) & 15, gate = (idx >> 13) & 1, dir = idx >> 14;
        const float* src = (gate ? p.w_i : p.w_r) + (size_t)((dir * 16 + head) * 64) * 64;
        const int i0 = 8 * (lane >> 5) + 16 * ks, j = (lane & 31) + 32 * cb;
        float v[8];
#pragma unroll
        for (int jj = 0; jj < 8; ++jj) v[jj] = -1.4426950408889634f * src[(i0 + jj) * 64 + j];
        u32x4 w; w.x = cvt_pk_bf16(v[0], v[1]); w.y = cvt_pk_bf16(v[2], v[3]); w.z = cvt_pk_bf16(v[4], v[5]); w.w = cvt_pk_bf16(v[6], v[7]);
        *(u32x4*)(p.ws + WS_WG + (size_t)idx * 16) = w;
    }
    for (int idx = gt; idx < 16384; idx += GT) {
        const f32x4 a = *(const f32x4*)(p.w_s + (size_t)idx * 8), b = *(const f32x4*)(p.w_s + (size_t)idx * 8 + 4);
        u32x4 w; w.x = cvt_pk_bf16(a[0], a[1]); w.y = cvt_pk_bf16(a[2], a[3]); w.z = cvt_pk_bf16(b[0], b[1]); w.w = cvt_pk_bf16(b[2], b[3]);
        *(u32x4*)(p.ws + WS_WS + (size_t)idx * 16) = w;
    }
    float* PE = (float*)(p.ws + WS_PE);
    for (int idx = gt; idx < 32768; idx += GT) {
        const int pos = idx >> 9, jc = idx & 511, j = jc & 255;
        const float freq = 1.0f / powf(10000.0f, (float)j / 256.0f);
        const float ang = (float)pos * freq;
        PE[idx] = jc < 256 ? sinf(ang) : cosf(ang);
    }
}

template <int MODE>
__device__ __forceinline__ void norm_phase(const Params& p, const bf16_t* delta, bf16_t* dsum_wb, const int tid, const int bid) {
    const bf16_t* D2 = (const bf16_t*)(p.ws + WS_D2);
    constexpr int NR = 4;
    const int lane = tid & 63, wv = tid >> 6;
    const int gw = bid * 8 + wv, nw = gridDim.x * 8;
    const float* PE = (const float*)(p.ws + WS_PE);
    const float* MOD = (const float*)(p.ws + WS_MOD);
    bf16_t* HM = (bf16_t*)(p.ws + WS_HMOD);
    const float* gvec = MODE == 1 ? p.norm1 : (MODE == 2 ? p.norm2 : (MODE == 3 ? p.norm3 : p.norm_f));
    f32x4 gn[4];
#pragma unroll
    for (int i = 0; i < 4; ++i) gn[i] = *(const f32x4*)(gvec + lane * 4 + 256 * i);
    for (int row0 = gw * NR; row0 < MTOK; row0 += nw * NR) {
        f32x4 v[NR][4]; u32x2 dq[NR][4];
#pragma unroll
        for (int r = 0; r < NR; ++r) {
            const int row = row0 + r;
            const float* src = row < MCTX ? p.x_prompt + (size_t)row * DM : p.x_sample + (size_t)(row - MCTX) * DM;
#pragma unroll
            for (int i = 0; i < 4; ++i) v[r][i] = __builtin_nontemporal_load((const f32x4*)(src + lane * 4 + 256 * i));
            if (MODE != 1) {
#pragma unroll
                for (int i = 0; i < 4; ++i) dq[r][i] = __builtin_nontemporal_load((const u32x2*)(delta + (size_t)row * DM + lane * 4 + 256 * i));
            }
        }
        if (row0 >= MCTX) {
#pragma unroll
            for (int r = 0; r < NR; ++r) { const int pos = (row0 + r - MCTX) & 4095, pr = pos >> 6, pc = pos & 63;
#pragma unroll
                for (int i = 0; i < 4; ++i) { const int col = lane * 4 + 256 * i; v[r][i] += *(const f32x4*)(PE + (i < 2 ? pr : pc) * 512 + (col & 511)); } }
        }
        if (MODE != 1 && row0 >= SPLIT_ROW0) {
#pragma unroll
            for (int r = 0; r < NR; ++r)
#pragma unroll
                for (int i = 0; i < 4; ++i) { const u32x2 e = __builtin_nontemporal_load((const u32x2*)(D2 + (size_t)(row0 + r) * DM + lane * 4 + 256 * i));
                    const f32x4 t = (f32x4){bflo(dq[r][i].x), bfhi(dq[r][i].x), bflo(dq[r][i].y), bfhi(dq[r][i].y)} + (f32x4){bflo(e.x), bfhi(e.x), bflo(e.y), bfhi(e.y)};
                    dq[r][i].x = cvt_pk_bf16(t[0], t[1]); dq[r][i].y = cvt_pk_bf16(t[2], t[3]);
                    if (dsum_wb) *(u32x2*)(dsum_wb + (size_t)(row0 + r) * DM + lane * 4 + 256 * i) = dq[r][i]; }
        }
        const float* mp = MOD + (size_t)modrow_of(row0) * NMODC + (MODE - 1) * 3 * 1024;
#pragma unroll
        for (int r = 0; r < NR; ++r) {
            const int row = row0 + r;
            float* orow = p.out + (size_t)row * DM;
            if (MODE != 1) {
#pragma unroll
                for (int i = 0; i < 4; ++i) v[r][i] += (f32x4){bflo(dq[r][i].x), bfhi(dq[r][i].x), bflo(dq[r][i].y), bfhi(dq[r][i].y)};
            }
            float ss = 0.f;
#pragma unroll
            for (int i = 0; i < 4; ++i) ss += v[r][i][0] * v[r][i][0] + v[r][i][1] * v[r][i][1] + v[r][i][2] * v[r][i][2] + v[r][i][3] * v[r][i][3];
#pragma unroll
            for (int o = 32; o >= 1; o >>= 1) ss += __shfl_xor(ss, o);
            const float rstd = __builtin_amdgcn_rsqf(ss * (1.0f / 1024.0f) + 1e-6f);
            if (MODE == 4) {
#pragma unroll
                for (int i = 0; i < 4; ++i) __builtin_nontemporal_store(v[r][i] * rstd * gn[i], (f32x4*)(orow + lane * 4 + 256 * i));
            } else {
#pragma unroll
                for (int i = 0; i < 4; ++i) { const int col = lane * 4 + 256 * i;
                    const f32x4 sh = *(const f32x4*)(mp + col), sc = *(const f32x4*)(mp + 1024 + col);
                    const f32x4 h = v[r][i] * rstd * gn[i] * (sc + 1.0f) + sh;
                    u32x2 w; w.x = cvt_pk_bf16(h[0], h[1]); w.y = cvt_pk_bf16(h[2], h[3]);
                    *(u32x2*)(HM + (size_t)row * DM + col) = w; }
            }
        }
    }
}

template <bool PASS2>
__device__ __forceinline__ void scan_phase(const Params& p, unsigned char* shm, const int tid, const int bid) {
    LAS bf16_t* Xc = (LAS bf16_t*)((LAS unsigned char*)shm);
    LAS bf16_t* Hf = (LAS bf16_t*)((LAS unsigned char*)shm + 36864);
    LAS bf16_t* Hb = (LAS bf16_t*)((LAS unsigned char*)shm + 36864 + 32768);
    const int lane = tid & 63, w = tid >> 6;
    const int dir = w & 1, cb = (w >> 1) & 1, hsel = w >> 2, hh = lane >> 5, l31 = lane & 31;
    const int G8 = gridDim.x >> 3, hp = bid & 7;
    bf16_t* Z = (bf16_t*)(p.ws + WS_Z);
    float* SUMA = (float*)(p.ws + WS_SUMA); float* SUMB = (float*)(p.ws + WS_SUMB);
    const int cg8 = tid & 15, tq = tid >> 4, c0 = hp * 128 + cg8 * 8;
    LAS float* CW = (LAS float*)((LAS unsigned char*)shm + 102400);
    for (int e = tid; e < 640; e += 512) CW[e] = e < 512 ? p.conv_w[(e >> 7) * 1024 + hp * 128 + (e & 127)] : p.conv_b[hp * 128 + (e & 127)];
    __syncthreads();
    const int head = hp * 2 + hsel, c = head * 64 + cb * 32 + l31;
    bf16x8 Wr[4], Wi[4];
    { const bf16x8* wg = (const bf16x8*)(p.ws + WS_WG);
#pragma unroll
        for (int ks = 0; ks < 4; ++ks) { Wr[ks] = wg[(((((dir * 2 + 0) * 16 + head) * 2 + cb) * 4 + ks) * 64) + lane]; Wi[ks] = wg[(((((dir * 2 + 1) * 16 + head) * 2 + cb) * 4 + ks) * 64) + lane]; } }
    const float brs = -1.4426950408889634f * p.b_r[dir * 1024 + c], bis = -1.4426950408889634f * p.b_i[dir * 1024 + c];
    const float lamv = p.lam[dir * 1024 + c];
    const float ls8l = 8.0f * 1.4426950408889634f * (fminf(lamv, 0.f) - log1pf(expf(-fabsf(lamv))));
    const LAS bf16_t* XcH = Xc + hsel * 128 * 72;
    LAS bf16_t* Hx = (dir ? Hb : Hf) + hsel * 128 * 64 + cb * 32 + l31;
    u32x4 rows[7];
    auto load_rows = [&](int sc) {
        int seqstart, T;
        if (sc < 64) { seqstart = (sc >> 1) * 256; T = 256; } else { seqstart = MCTX + ((sc - 64) >> 5) * 4096; T = 4096; }
        const int tok0 = sc * 128, pos0 = tok0 - seqstart;
#pragma unroll
        for (int rr = 0; rr < 7; ++rr) { const int tt = 4 * tq - 2 + rr, pp = pos0 + tt;
            rows[rr] = (pp >= 0 && pp < T) ? *(const u32x4*)(Z + (size_t)(tok0 + tt) * 4096 + c0) : (u32x4){0u, 0u, 0u, 0u}; }
    };
    int sc = bid >> 3;
    if (sc < NSC) load_rows(sc);
    for (; sc < NSC; sc += G8) {
        const int tok0 = sc * 128;
        {
            float a[4][8];
            { const f32x4 b0 = *(const LAS f32x4*)(CW + 512 + cg8 * 8), b1 = *(const LAS f32x4*)(CW + 512 + cg8 * 8 + 4);
#pragma unroll
                for (int e = 0; e < 4; ++e) { a[e][0] = b0[0]; a[e][1] = b0[1]; a[e][2] = b0[2]; a[e][3] = b0[3]; a[e][4] = b1[0]; a[e][5] = b1[1]; a[e][6] = b1[2]; a[e][7] = b1[3]; } }
#pragma unroll
            for (int k = 0; k < 4; ++k) { const f32x4 w0 = *(const LAS f32x4*)(CW + k * 128 + cg8 * 8), w1 = *(const LAS f32x4*)(CW + k * 128 + cg8 * 8 + 4);
#pragma unroll
                for (int e = 0; e < 4; ++e) { const u32x4 raw = rows[e + k];
                    a[e][0] += w0[0] * bflo(raw.x); a[e][1] += w0[1] * bfhi(raw.x); a[e][2] += w0[2] * bflo(raw.y); a[e][3] += w0[3] * bfhi(raw.y);
                    a[e][4] += w1[0] * bflo(raw.z); a[e][5] += w1[1] * bfhi(raw.z); a[e][6] += w1[2] * bflo(raw.w); a[e][7] += w1[3] * bfhi(raw.w); } }
#pragma unroll
            for (int e = 0; e < 4; ++e) { u32x4 wq; wq.x = cvt_pk_bf16(a[e][0], a[e][1]); wq.y = cvt_pk_bf16(a[e][2], a[e][3]); wq.z = cvt_pk_bf16(a[e][4], a[e][5]); wq.w = cvt_pk_bf16(a[e][6], a[e][7]);
                *(LAS u32x4*)(Xc + ((cg8 >> 3) * 128 + 4 * tq + e) * 72 + (cg8 & 7) * 8) = wq; }
        }
        __syncthreads();
        if (sc + G8 < NSC) load_rows(sc + G8);
        u32x4 ggr[4];
        if (PASS2) {
#pragma unroll
            for (int i = 0; i < 4; ++i) { const int e = tid + 512 * i; ggr[i] = *(const u32x4*)(Z + (size_t)(tok0 + (e >> 4)) * 4096 + 1024 + hp * 128 + (e & 15) * 8); }
        }
        float s = 0.f, PA = 1.f, PB = 0.f;
        if (PASS2) s = SUMB[(size_t)(dir * NSC + sc) * 1024 + c];
        auto tiles = [&](auto dirc) {
        constexpr int DIR = decltype(dirc)::value;
#pragma unroll 2
        for (int tile = 0; tile < 4; ++tile) {
            const int mA = tile * 32 + l31, tokA = DIR ? 127 - mA : mA;
            f32x16 ar, ai;
#pragma unroll
            for (int i = 0; i < 16; ++i) { ar[i] = brs; ai[i] = bis; }
#pragma unroll
            for (int ks = 0; ks < 4; ++ks) { const bf16x8 a = *(const LAS bf16x8*)(XcH + tokA * 72 + ks * 16 + hh * 8);
                ar = __builtin_amdgcn_mfma_f32_32x32x16_bf16(a, Wr[ks], ar, 0, 0, 0); ai = __builtin_amdgcn_mfma_f32_32x32x16_bf16(a, Wi[ks], ai, 0, 0, 0); }
            f32x2 a2[2][4], b2[2][4];
#pragma unroll
            for (int gp = 0; gp < 2; ++gp)
#pragma unroll
                for (int jj = 0; jj < 4; ++jj) {
                    const int i0 = 8 * gp + jj, i1 = i0 + 4;
                    const int m0 = tile * 32 + jj + 16 * gp + 4 * hh, m1 = m0 + 8, t0 = DIR ? 127 - m0 : m0, t1 = DIR ? 127 - m1 : m1;
                    const f32x2 xc = {bf2f(XcH[t0 * 72 + cb * 32 + l31]), bf2f(XcH[t1 * 72 + cb * 32 + l31])};
                    const f32x2 e1 = {__builtin_amdgcn_exp2f(__builtin_amdgcn_fmed3f(ar[i0], -3.0e38f, 60.f)), __builtin_amdgcn_exp2f(__builtin_amdgcn_fmed3f(ar[i1], -3.0e38f, 60.f))};
                    const f32x2 e2 = {__builtin_amdgcn_exp2f(__builtin_amdgcn_fmed3f(ai[i0], -3.0e38f, 60.f)), __builtin_amdgcn_exp2f(__builtin_amdgcn_fmed3f(ai[i1], -3.0e38f, 60.f))};
                    const f32x2 d1 = e1 + 1.0f, d2 = e2 + 1.0f, dd = d1 * d2;
                    const f32x2 R = {__builtin_amdgcn_rcpf(dd.x), __builtin_amdgcn_rcpf(dd.y)};
                    const f32x2 r = R * d2, ig = R * d1;
                    const f32x2 t = r * ls8l;
                    const f32x2 a = {__builtin_amdgcn_exp2f(t.x), __builtin_amdgcn_exp2f(t.y)};
                    const f32x2 om = 1.0f - a * a;
                    const f32x2 mult = {__builtin_amdgcn_sqrtf(om.x), __builtin_amdgcn_sqrtf(om.y)};
                    a2[gp][jj] = a; b2[gp][jj] = mult * ig * xc;
                }
            float gA[4], gB[4];
#pragma unroll
            for (int gp = 0; gp < 2; ++gp) { f32x2 A = a2[gp][0], B = b2[gp][0];
#pragma unroll
                for (int jj = 1; jj < 4; ++jj) { B = a2[gp][jj] * B + b2[gp][jj]; A = A * a2[gp][jj]; }
                gA[2 * gp] = A.x; gA[2 * gp + 1] = A.y; gB[2 * gp] = B.x; gB[2 * gp + 1] = B.y; }
            float st[4];
#pragma unroll
            for (int g = 0; g < 4; ++g) {
                const auto ra = __builtin_amdgcn_permlane32_swap(__float_as_uint(gA[g]), __float_as_uint(gA[g]), false, false);
                const auto rb = __builtin_amdgcn_permlane32_swap(__float_as_uint(gB[g]), __float_as_uint(gB[g]), false, false);
                const float fA = __uint_as_float(ra[0]), sA = __uint_as_float(ra[1]), fB = __uint_as_float(rb[0]), sB = __uint_as_float(rb[1]);
                if (PASS2) { const float s0 = s, s1 = fA * s0 + fB; s = sA * s1 + sB; st[g] = hh ? s1 : s0; }
                else { PB = fA * PB + fB; PA *= fA; PB = sA * PB + sB; PA *= sA; }
            }
            if (PASS2) {
#pragma unroll
                for (int gp = 0; gp < 2; ++gp) { f32x2 h = {st[2 * gp], st[2 * gp + 1]};
#pragma unroll
                    for (int jj = 0; jj < 4; ++jj) { h = a2[gp][jj] * h + b2[gp][jj];
                        const int m0 = tile * 32 + jj + 16 * gp + 4 * hh, m1 = m0 + 8, t0 = DIR ? 127 - m0 : m0, t1 = DIR ? 127 - m1 : m1;
                        const unsigned pk = cvt_pk_bf16(h.x, h.y);
                        Hx[t0 * 64] = (bf16_t)(pk & 0xffffu); Hx[t1 * 64] = (bf16_t)(pk >> 16); } }
            }
        }
        };
        if (__builtin_amdgcn_readfirstlane(dir)) tiles(std::integral_constant<int, 1>{}); else tiles(std::integral_constant<int, 0>{});
        if (PASS2) {
            __syncthreads();
#pragma unroll
            for (int i = 0; i < 4; ++i) {
                const int e = tid + 512 * i, t = e >> 4, c8 = e & 15;
                const int ho = ((c8 >> 3) * 128 + t) * 64 + (c8 & 7) * 8;
                const u32x4 f = *(const LAS u32x4*)(Hf + ho), b = *(const LAS u32x4*)(Hb + ho), gq = ggr[i];
                u32x4 wq; wq.x = cvt_pk_bf16((bflo(f.x) + bflo(b.x)) * bflo(gq.x), (bfhi(f.x) + bfhi(b.x)) * bfhi(gq.x));
                wq.y = cvt_pk_bf16((bflo(f.y) + bflo(b.y)) * bflo(gq.y), (bfhi(f.y) + bfhi(b.y)) * bfhi(gq.y));
                wq.z = cvt_pk_bf16((bflo(f.z) + bflo(b.z)) * bflo(gq.z), (bfhi(f.z) + bfhi(b.z)) * bfhi(gq.z));
                wq.w = cvt_pk_bf16((bflo(f.w) + bflo(b.w)) * bflo(gq.w), (bfhi(f.w) + bfhi(b.w)) * bfhi(gq.w));
                *(u32x4*)(Z + (size_t)(tok0 + t) * 4096 + 1024 + hp * 128 + c8 * 8) = wq;
            }
        } else {
            if (hh == 0) { const size_t ix = (size_t)(dir * NSC + sc) * 1024 + c; SUMA[ix] = PA; SUMB[ix] = PB; }
            __syncthreads();
        }
    }
}

__device__ __forceinline__ void carry_phase(const Params& p, const int tid, const int bid) {
    const float* SUMA = (const float*)(p.ws + WS_SUMA); float* SUMB = (float*)(p.ws + WS_SUMB);
    for (int idx = bid * 512 + tid; idx < 2 * 40 * 1024; idx += gridDim.x * 512) {
        const int c = idx & 1023, sq = (idx >> 10) % 40, dir = idx / 40960;
        int scb, nch; float s = 0.f;
        if (sq < 32) { scb = 2 * sq; nch = 2; } else { scb = 64 + 32 * (sq - 32); nch = 32; s = (dir ? p.st_b : p.st_f)[(sq - 32) * 1024 + c]; }
        for (int k0 = 0; k0 < nch; k0 += 8) {
            float A[8], B[8];
#pragma unroll
            for (int kk = 0; kk < 8; ++kk) { const int k = k0 + kk; if (k < nch) { const int ch = dir ? nch - 1 - k : k; const size_t ix = (size_t)(dir * NSC + scb + ch) * 1024 + c; A[kk] = SUMA[ix]; B[kk] = SUMB[ix]; } else { A[kk] = 1.f; B[kk] = 0.f; } }
#pragma unroll
            for (int kk = 0; kk < 8; ++kk) { const int k = k0 + kk; if (k < nch) { const int ch = dir ? nch - 1 - k : k; const size_t ix = (size_t)(dir * NSC + scb + ch) * 1024 + c; SUMB[ix] = s; s = A[kk] * s + B[kk]; } }
        }
        if (sq < 32) p.out[(dir ? OUT_SB : OUT_SF) + sq * 1024 + c] = s;
    }
}

__device__ __forceinline__ void gmlp_phase(const Params& p, unsigned char* shm, const int tid, const int bid) {
    bf16_t* VnT = (bf16_t*)shm;
    bf16_t* OT = (bf16_t*)(shm + 34816);
    float* rstd = (float*)(shm + 2 * 34816);
    const int lane = tid & 63, w = tid >> 6, pb = w & 3, chh = w >> 2, hh = lane >> 5, l31 = lane & 31;
    const int G8 = gridDim.x >> 3, g = bid & 7;
    bf16_t* Z = (bf16_t*)(p.ws + WS_Z);
    const float* VSS = (const float*)(p.ws + WS_VSS);
    bf16x8 Af[8];
    { const bf16_t* wrow = (const bf16_t*)(p.ws + WS_WS) + ((size_t)g * 128 + pb * 32 + l31) * 128 + hh * 8;
#pragma unroll
        for (int ks = 0; ks < 8; ++ks) Af[ks] = *(const bf16x8*)(wrow + ks * 16); }
    float bsv[16];
#pragma unroll
    for (int i = 0; i < 16; ++i) bsv[i] = p.b_s[g * 128 + pb * 32 + (i & 3) + 8 * (i >> 2) + 4 * hh];
    f32x4 gnv[4][2];
#pragma unroll
    for (int i = 0; i < 4; ++i) { const int cc = ((tid >> 7) + 4 * i) * 8; gnv[i][0] = *(const f32x4*)(p.gmlp_norm + g * 128 + cc); gnv[i][1] = *(const f32x4*)(p.gmlp_norm + g * 128 + cc + 4); }
    const int qp = tid & 63, cgq = tid >> 6;
    f32x4 gnp[2][2];
#pragma unroll
    for (int i = 0; i < 2; ++i) { const int cc = (cgq + 8 * i) * 8; gnp[i][0] = *(const f32x4*)(p.gmlp_norm + g * 128 + cc); gnp[i][1] = *(const f32x4*)(p.gmlp_norm + g * 128 + cc + 4); }
    u32x4 raw[2][2]; f32x4 vs[4]; u32x4 gu[4], gun[4];
    auto load_v = [&](int sc) {
        const int tok0 = sc * 128;
#pragma unroll
        for (int i = 0; i < 2; ++i)
#pragma unroll
            for (int h = 0; h < 2; ++h) raw[i][h] = *(const u32x4*)(Z + (size_t)(tok0 + 2 * qp + h) * 4096 + 3072 + g * 128 + (cgq + 8 * i) * 8);
        if (tid < 128) { const f32x4* vp = (const f32x4*)(VSS + (size_t)(tok0 + tid) * 16); vs[0] = vp[0]; vs[1] = vp[1]; vs[2] = vp[2]; vs[3] = vp[3]; }
#pragma unroll
        for (int i = 0; i < 4; ++i) { const int e = tid + 512 * i; gun[i] = *(const u32x4*)(Z + (size_t)(tok0 + (e >> 4)) * 4096 + 2048 + g * 128 + (e & 15) * 8); }
    };
    int sc = bid >> 3;
    if (sc < NSC) load_v(sc);
    for (; sc < NSC; sc += G8) {
        const int tok0 = sc * 128;
        if (tid < 128) { const f32x4 a = vs[0] + vs[1] + vs[2] + vs[3]; rstd[tid] = __builtin_amdgcn_rsqf((a[0] + a[1] + a[2] + a[3]) * (1.0f / 1024.0f) + 1e-6f); }
#pragma unroll
        for (int i = 0; i < 4; ++i) gu[i] = gun[i];
        __syncthreads();
        { const float rs0 = rstd[2 * qp], rs1 = rstd[2 * qp + 1];
#pragma unroll
            for (int i = 0; i < 2; ++i) { unsigned* vp = (unsigned*)(VnT + (cgq + 8 * i) * 8 * 136 + 2 * qp); const u32x4 a4 = raw[i][0], b4 = raw[i][1];
                const f32x4 g0 = gnp[i][0], g1 = gnp[i][1];
                vp[0 * 68] = cvt_pk_bf16(bflo(a4.x) * rs0 * g0[0], bflo(b4.x) * rs1 * g0[0]); vp[1 * 68] = cvt_pk_bf16(bfhi(a4.x) * rs0 * g0[1], bfhi(b4.x) * rs1 * g0[1]);
                vp[2 * 68] = cvt_pk_bf16(bflo(a4.y) * rs0 * g0[2], bflo(b4.y) * rs1 * g0[2]); vp[3 * 68] = cvt_pk_bf16(bfhi(a4.y) * rs0 * g0[3], bfhi(b4.y) * rs1 * g0[3]);
                vp[4 * 68] = cvt_pk_bf16(bflo(a4.z) * rs0 * g1[0], bflo(b4.z) * rs1 * g1[0]); vp[5 * 68] = cvt_pk_bf16(bfhi(a4.z) * rs0 * g1[1], bfhi(b4.z) * rs1 * g1[1]);
                vp[6 * 68] = cvt_pk_bf16(bflo(a4.w) * rs0 * g1[2], bflo(b4.w) * rs1 * g1[2]); vp[7 * 68] = cvt_pk_bf16(bfhi(a4.w) * rs0 * g1[3], bfhi(b4.w) * rs1 * g1[3]); } }
        __syncthreads();
        if (sc + G8 < NSC) load_v(sc + G8);
        f32x16 acc0, acc1;
#pragma unroll
        for (int i = 0; i < 16; ++i) { acc0[i] = bsv[i]; acc1[i] = bsv[i]; }
        const bf16_t* v0p = VnT + (chh * 64 + l31) * 136 + hh * 8;
#pragma unroll
        for (int ks = 0; ks < 8; ++ks) {
            const bf16x8 b0 = *(const bf16x8*)(v0p + ks * 16), b1 = *(const bf16x8*)(v0p + 32 * 136 + ks * 16);
            acc0 = __builtin_amdgcn_mfma_f32_32x32x16_bf16(Af[ks], b0, acc0, 0, 0, 0);
            acc1 = __builtin_amdgcn_mfma_f32_32x32x16_bf16(Af[ks], b1, acc1, 0, 0, 0);
        }
#pragma unroll
        for (int i = 0; i < 16; ++i) { const int pr = pb * 32 + (i & 3) + 8 * (i >> 2) + 4 * hh;
            OT[pr * 136 + chh * 64 + l31] = f2bf(acc0[i]); OT[pr * 136 + chh * 64 + 32 + l31] = f2bf(acc1[i]); }
        __syncthreads();
#pragma unroll
        for (int i = 0; i < 4; ++i) { const int e = tid + 512 * i, pr = e >> 4, c8 = e & 15;
            const u32x4 o = *(const u32x4*)(OT + pr * 136 + c8 * 8), u4 = gu[i];
            u32x4 wq; wq.x = cvt_pk_bf16(bflo(o.x) * bflo(u4.x), bfhi(o.x) * bfhi(u4.x)); wq.y = cvt_pk_bf16(bflo(o.y) * bflo(u4.y), bfhi(o.y) * bfhi(u4.y));
            wq.z = cvt_pk_bf16(bflo(o.z) * bflo(u4.z), bfhi(o.z) * bfhi(u4.z)); wq.w = cvt_pk_bf16(bflo(o.w) * bflo(u4.w), bfhi(o.w) * bfhi(u4.w));
            *(u32x4*)(Z + (size_t)(tok0 + pr) * 4096 + 2048 + g * 128 + c8 * 8) = wq; }
    }
}

#define XB_TMO      128
#define XB_XCNT(j)  (256  + 64 * (j))
#define XB_XSUB(j)  (1280 + 64 * (j))
#define XB_XGEN(j)  (2304 + 64 * (j))
#define XB_TOP      3328
#define XB_TOPGEN   3392
#define XCD_BAR_WORDS 3456
#define XB_SPIN_CAP (1u << 18)

__device__ __forceinline__ unsigned xb_ld(unsigned* p)              { return __hip_atomic_load(p, __ATOMIC_RELAXED, __HIP_MEMORY_SCOPE_AGENT); }
__device__ __forceinline__ unsigned xb_add(unsigned* p, unsigned v) { return __hip_atomic_fetch_add(p, v, __ATOMIC_RELAXED, __HIP_MEMORY_SCOPE_AGENT); }
__device__ __forceinline__ unsigned xb_xcc_id() { return (unsigned)__builtin_amdgcn_s_getreg((3 << 11) | 20) & 0xFu; }
#define XB_SPIN(cond, bar) do { unsigned _sp = 0; while (cond) { __builtin_amdgcn_s_sleep(1); \
    if ((++_sp & 255u) == 0u) { if (xb_ld(&(bar)[XB_TMO])) break; if (_sp > XB_SPIN_CAP) { atomicAdd(&(bar)[XB_TMO], 1u); break; } } } } while (0)

struct XcdBarrier {
    unsigned* bar; unsigned x;
    volatile LAS unsigned* st;
};

__device__ __forceinline__ XcdBarrier xcd_barrier_post(unsigned* bar, volatile LAS unsigned* st) {
    XcdBarrier b; b.bar = bar; b.x = xb_xcc_id(); b.st = st;
    if (threadIdx.x == 0) (void)xb_add(&bar[XB_XCNT(b.x)], 1u);
    return b;
}
__device__ __forceinline__ void xcd_barrier_complete(unsigned* bar, unsigned x, unsigned& nloc, unsigned& nx) {
    const unsigned G = gridDim.x * gridDim.y * gridDim.z;
    unsigned sum, cnt, mine, sp = 0u;
    for (;;) {
        sum = 0u; cnt = 0u; mine = 0u;
#pragma unroll
        for (unsigned j = 0; j < 16; ++j) { const unsigned c = xb_ld(&bar[XB_XCNT(j)]); sum += c; cnt += (c > 0u) ? 1u : 0u; mine = (j == x) ? c : mine; }
        if (sum == G) break;
        __builtin_amdgcn_s_sleep(1);
        if ((++sp & 255u) == 0u) { if (xb_ld(&bar[XB_TMO])) break; if (sp > XB_SPIN_CAP) { atomicAdd(&bar[XB_TMO], 1u); break; } }
    }
    nloc = mine > 0u ? mine : 1u; nx = cnt > 0u ? cnt : 1u;
}

__device__ __forceinline__ void xcd_barrier(const XcdBarrier& b) {
    asm volatile("s_waitcnt vmcnt(0)" ::: "memory");
    __syncthreads();
    if (threadIdx.x == 0) {
        unsigned* bar = b.bar;
        __builtin_amdgcn_s_waitcnt(0);
        unsigned nloc = b.st[0], nx = b.st[1];
        if (nloc == 0u) { xcd_barrier_complete(bar, b.x, nloc, nx); b.st[0] = nloc; b.st[1] = nx; }
        const unsigned old = xb_add(&bar[XB_XSUB(b.x)], 1u);
        const unsigned gen = old / nloc;
        if (old + 1u == (gen + 1u) * nloc) {
            __builtin_amdgcn_fence(__ATOMIC_RELEASE, "agent");
            asm volatile("s_waitcnt vmcnt(0)" ::: "memory");
            const unsigned og = xb_add(&bar[XB_TOP], 1u);
            const unsigned tg = og / nx;
            if (og + 1u == (tg + 1u) * nx) xb_add(&bar[XB_TOPGEN], 1u);
            else XB_SPIN(xb_ld(&bar[XB_TOPGEN]) == tg, bar);
            __builtin_amdgcn_fence(__ATOMIC_ACQUIRE, "agent");
            xb_add(&bar[XB_XGEN(b.x)], 1u);
            asm volatile("s_waitcnt vmcnt(0)" ::: "memory");
        } else {
            XB_SPIN(xb_ld(&bar[XB_XGEN(b.x)]) == gen, bar);
            __builtin_amdgcn_fence(__ATOMIC_ACQUIRE, "agent");
            asm volatile("s_waitcnt vmcnt(0)" ::: "memory");
        }
    }
    __syncthreads();
}

__global__ __launch_bounds__(512, 2) void mega(Params p) {
    extern __shared__ __attribute__((aligned(16))) unsigned char shm[];
    cg::grid_group grid = cg::this_grid();
    unsigned char* ws = p.ws;
#if ONE_LAUNCH
    volatile LAS unsigned* bst = (volatile LAS unsigned*)((LAS unsigned char*)shm + 131072);
    if (threadIdx.x == 0) { bst[0] = 0u; bst[1] = 0u; }
    __syncthreads();
    const XcdBarrier xbar = xcd_barrier_post((unsigned*)(ws + WS_BAR), bst);
#endif
    int ph0 = p.ph_lo;
    if (ph0 == 0) {
        int tid = threadIdx.x, bid = blockIdx.x;
        asm volatile("" : "+v"(tid), "+s"(bid));
        prep_phase(p, shm, tid, bid);
        ph0 = 1;
#if ONE_LAUNCH
        if (ph0 < p.ph_hi) xcd_barrier(xbar);
#endif
    }
    for (int ph = ph0; ph < p.ph_hi; ++ph) {
      const int nrep = (ph == PROBE_PH) ? PROBE_REP : 1;
      for (int rep = 0; rep < nrep; ++rep) {
        int tid = threadIdx.x, bid = blockIdx.x;
        asm volatile("" : "+v"(tid), "+s"(bid));
        if (ph == 1) norm_phase<1>(p, nullptr, nullptr, tid, bid);
        else if (ph == 2 || ph == 13) {
            pg8::Gemm g{(const bf16_t*)(ws + WS_HMOD), 1024, (const bf16_t*)(ws + (ph == 2 ? WS_FF1 : WS_FF2)), MTOK, 5632, 1024};
            pg8::StaticOrder S; S.init(MTOK, 5632, gridDim.x, bid, 16);
            EpiSwiGLU E{(bf16_t*)(ws + WS_Z)};
            pg8::gemm_phase((LAS unsigned char*)shm, g, S, E, tid);
        } else if (ph == 3 || ph == 14) {
            pg8::Gemm g{(const bf16_t*)(ws + WS_Z), DFF, (const bf16_t*)(ws + (ph == 3 ? WS_FF1D : WS_FF2D)), MTOK, 1024, DFF};
            pg8::BalancedOrder S; S.init(MTOK, 1024, gridDim.x, bid, 44);
            if (ph == 3) { EpiDelta<false> E{(bf16_t*)p.out, nullptr, (const float*)(ws + WS_MOD) + 2 * 1024, 0.5f, (bf16_t*)(ws + WS_D2)}; pg8::gemm_phase((LAS unsigned char*)shm, g, S, E, tid); }
            else { EpiDelta<true> E{(bf16_t*)(ws + WS_HMOD), (const bf16_t*)p.out, (const float*)(ws + WS_MOD) + 8 * 1024, 0.5f, (bf16_t*)(ws + WS_D2)}; pg8::gemm_phase((LAS unsigned char*)shm, g, S, E, tid); }
        } else if (ph == 4) norm_phase<2>(p, (const bf16_t*)p.out, (bf16_t*)p.out, tid, bid);
        else if (ph == 5) {
            pg8::Gemm g{(const bf16_t*)(ws + WS_HMOD), 1024, (const bf16_t*)(ws + WS_IN), MTOK, 4096, 1024};
            pg8::StaticOrder S; S.init(MTOK, 4096, gridDim.x, bid, 16);
            EpiZ E{(bf16_t*)(ws + WS_Z), (float*)(ws + WS_VSS)};
            pg8::gemm_phase((LAS unsigned char*)shm, g, S, E, tid);
        } else if (ph == 6) scan_phase<false>(p, shm, tid, bid);
        else if (ph == 7) carry_phase(p, tid, bid);
        else if (ph == 8) {
            if ((bid >> 3) & 1) { gmlp_phase(p, shm, tid, bid); __syncthreads(); scan_phase<true>(p, shm, tid, bid); }
            else { scan_phase<true>(p, shm, tid, bid); __syncthreads(); gmlp_phase(p, shm, tid, bid); } }
        else if (ph == 9) {
            pg8::Gemm g{(const bf16_t*)(ws + WS_HMOD), 1024, (const bf16_t*)(ws + WS_IN) + (size_t)4096 * 1024, MTOK, 2048, 1024};
            pg8::StaticOrder S; S.init(MTOK, 2048, gridDim.x, bid, 16);
            EpiGates E{(bf16_t*)(ws + WS_Z)};
            pg8::gemm_phase((LAS unsigned char*)shm, g, S, E, tid);
        } else if (ph == 10) {
            pg8::Gemm g{(const bf16_t*)(ws + WS_Z) + 1024, 4096, (const bf16_t*)(ws + WS_CAT), MTOK, 1024, 2048};
            pg8::StaticOrder S; S.init(MTOK, 1024, gridDim.x, bid, 32);
            EpiMerge E{(const bf16_t*)(ws + WS_Z), (bf16_t*)(ws + WS_HMOD)};
            pg8::gemm_phase((LAS unsigned char*)shm, g, S, E, tid);
            if (gridDim.x == 256 && bid >= 128) transpose_range(ws, shm, tid, bid - 128, 128, 2112, 2);
        } else if (ph == 11) {
            pg8::Gemm g{(const bf16_t*)(ws + WS_HMOD), 1024, (const bf16_t*)(ws + WS_OUT), MTOK, 1024, 1024};
            pg8::BalancedOrder S; S.init(MTOK, 1024, gridDim.x, bid, 16);
            EpiDelta<true> E{(bf16_t*)p.out, (const bf16_t*)p.out, (const float*)(ws + WS_MOD) + 5 * 1024, 1.0f, (bf16_t*)(ws + WS_D2)};
            pg8::gemm_phase((LAS unsigned char*)shm, g, S, E, tid);
        } else if (ph == 12) norm_phase<3>(p, (const bf16_t*)p.out, (bf16_t*)p.out, tid, bid);
        else if (ph == 15) norm_phase<4>(p, (const bf16_t*)(ws + WS_HMOD), nullptr, tid, bid);
#if ONE_LAUNCH
        if (ph + 1 < p.ph_hi || rep + 1 < nrep) { if (p.ph_lo > 1000) grid.sync(); else xcd_barrier(xbar); }
        if (PROBE_SYNCS > 0 && ph == 1) { for (int k = 0; k < PROBE_SYNCS; ++k) xcd_barrier(xbar); }
#endif
      }
    }
}

extern "C" void kernel_launch(void* const* d_in, const int* in_sizes, int n_in, void* d_out, int out_size, void* d_ws, size_t ws_size, hipStream_t stream) {
    static int grid = 0;
    if (grid == 0) {
        if (n_in != 32 || ws_size < WS_END) { fprintf(stderr, "kernel_launch: need 32 inputs and >= %zu bytes of workspace; got n_in %d, ws %zu; nothing launched\n", (size_t)WS_END, n_in, ws_size); grid = -1; return; }
        int dev = 0, cus = 0, per_cu = 0;
        if (hipGetDevice(&dev) != hipSuccess || hipDeviceGetAttribute(&cus, hipDeviceAttributeMultiprocessorCount, dev) != hipSuccess) { grid = -1; return; }
        if (hipFuncSetAttribute((const void*)mega, hipFuncAttributeMaxDynamicSharedMemorySize, LDS_BYTES) != hipSuccess) { fprintf(stderr, "kernel_launch: hipFuncSetAttribute failed\n"); grid = -1; return; }
        if (hipOccupancyMaxActiveBlocksPerMultiprocessor(&per_cu, (const void*)mega, 512, LDS_BYTES) != hipSuccess || per_cu < 1) { fprintf(stderr, "kernel_launch: occupancy query says %d\n", per_cu); per_cu = 1; }
        (void)hipGetLastError();
        grid = cus;
    }
    if (grid < 0) return;
    Params p{};
    const float** pp = (const float**)&p;
    for (int i = 0; i < 32; ++i) pp[i] = (const float*)d_in[i];
    p.out = (float*)d_out; p.ws = (unsigned char*)d_ws;
#if ONE_LAUNCH
    (void)hipMemsetAsync((unsigned char*)d_ws + WS_BAR, 0, 16384, stream);
    p.ph_lo = 0; p.ph_hi = NPH;
    void* args[] = {&p};
    hipError_t e = hipLaunchCooperativeKernel((const void*)mega, dim3(grid), dim3(512), args, LDS_BYTES, stream);
    if (e != hipSuccess) fprintf(stderr, "kernel_launch: cooperative launch failed: %s (grid %d)\n", hipGetErrorString(e), grid);
#else
    for (int ph = 0; ph < NPH; ++ph) {
        p.ph_lo = ph; p.ph_hi = ph + 1;
        hipLaunchKernelGGL(mega, dim3(grid), dim3(512), LDS_BYTES, stream, p);
    }
#endif
}
```

```cpp
#include <hip/hip_runtime.h>
#include <hip/hip_cooperative_groups.h>
#include <cstdio>
#include <type_traits>
namespace cg = cooperative_groups;

#ifndef EPI_REP
#define EPI_REP 1
#endif
#ifndef PROBE_SYNCS
#define PROBE_SYNCS 0
#endif
#ifndef PROBE_PH
#define PROBE_PH (-1)
#define PROBE_REP 1
#endif
#ifndef ONE_LAUNCH
#define ONE_LAUNCH 1
#endif

#define LAS __attribute__((address_space(3)))
typedef unsigned short bf16_t;
typedef short bf16x8 __attribute__((ext_vector_type(8)));
typedef float f32x4 __attribute__((ext_vector_type(4)));
typedef float f32x16 __attribute__((ext_vector_type(16)));
typedef unsigned u32x4 __attribute__((ext_vector_type(4)));
typedef unsigned u32x2 __attribute__((ext_vector_type(2)));

constexpr int MTOK = 40960, MCTX = 8192, DM = 1024, DFF = 2816, NMODC = 9216;
constexpr int NSC = 320;
constexpr size_t OUT_SF = (size_t)MTOK * DM, OUT_SB = OUT_SF + 32 * 1024;
constexpr int LDS_BYTES = 131072 + 64;
constexpr int NPH = 16;

constexpr size_t WS_FF1 = 0;
constexpr size_t WS_FF1D = WS_FF1 + (size_t)5632 * 1024 * 2;
constexpr size_t WS_FF2 = WS_FF1D + (size_t)1024 * 2816 * 2;
constexpr size_t WS_FF2D = WS_FF2 + (size_t)5632 * 1024 * 2;
constexpr size_t WS_IN = WS_FF2D + (size_t)1024 * 2816 * 2;
constexpr size_t WS_CAT = WS_IN + (size_t)6144 * 1024 * 2;
constexpr size_t WS_OUT = WS_CAT + (size_t)1024 * 2048 * 2;
constexpr size_t WS_WG = WS_OUT + (size_t)1024 * 1024 * 2;
constexpr size_t WS_WS = WS_WG + (size_t)2 * 2 * 16 * 4096 * 2;
constexpr size_t WS_PE = WS_WS + (size_t)8 * 128 * 128 * 2;
constexpr size_t WS_MOD = WS_PE + (size_t)64 * 512 * 4;
constexpr size_t WS_VSS = WS_MOD + (size_t)9 * 9216 * 4;
constexpr size_t WS_SUMA = WS_VSS + (size_t)MTOK * 16 * 4;
constexpr size_t WS_SUMB = WS_SUMA + (size_t)2 * NSC * 1024 * 4;
constexpr size_t WS_HMOD = WS_SUMB + (size_t)2 * NSC * 1024 * 4;
constexpr size_t WS_Z = WS_HMOD + (size_t)MTOK * 1024 * 2;
constexpr size_t WS_BAR = WS_Z + (size_t)MTOK * 4096 * 2;
constexpr size_t WS_END = WS_BAR + 16384;
constexpr size_t WS_D2 = WS_Z + ((size_t)240 << 20);
constexpr int SPLIT_ROW0 = 32768;
constexpr size_t WS_PTAB = WS_BAR + 15360;

struct Params {
    const float* x_prompt; const float* x_sample; const float* st_f; const float* st_b; const float* c; const float* c_ctx;
    const float* w_mod; const float* b_mod; const float* norm1; const float* norm2; const float* norm3;
    const float* ff1_gate; const float* ff1_up; const float* ff1_down; const float* w_in; const float* conv_w; const float* conv_b;
    const float* w_r; const float* b_r; const float* w_i; const float* b_i; const float* lam; const float* gmlp_norm; const float* w_s; const float* b_s;
    const float* w_br; const float* w_bg; const float* w_out; const float* ff2_gate; const float* ff2_up; const float* ff2_down; const float* norm_f;
    float* out; unsigned char* ws; int ph_lo, ph_hi;
};

__device__ __forceinline__ float bf2f(unsigned b) { return __uint_as_float(b << 16); }
__device__ __forceinline__ float bflo(unsigned w) { return __uint_as_float(w << 16); }
__device__ __forceinline__ float bfhi(unsigned w) { return __uint_as_float(w & 0xffff0000u); }
typedef float f32x2 __attribute__((ext_vector_type(2)));
typedef __bf16 bf16x2_t __attribute__((ext_vector_type(2)));
__device__ __forceinline__ unsigned cvt_pk_bf16(float lo, float hi) { const f32x2 v = {lo, hi}; return __builtin_bit_cast(unsigned, __builtin_convertvector(v, bf16x2_t)); }
__device__ __forceinline__ bf16_t f2bf(float f) { return (bf16_t)(cvt_pk_bf16(f, 0.f) & 0xffffu); }
__device__ __forceinline__ float sigm(float x) { return __builtin_amdgcn_rcpf(1.0f + __builtin_amdgcn_exp2f(-1.4426950408889634f * x)); }
__device__ __forceinline__ float gelu_t(float x) { const float y2 = x * (-2.302208198f - 0.1029432397f * x * x); return x * __builtin_amdgcn_rcpf(1.0f + __builtin_amdgcn_exp2f(y2)); }
__device__ __forceinline__ int modrow_of(int row) { return row < MCTX ? 8 : ((row - MCTX) >> 12); }

namespace pg8 {
constexpr int BM = 256, BK = 64, HALF = 128, HTB = HALF * BK * 2, STAGE_BYTES = 8 * HTB, NXCD = 8, WGM = 8;
__host__ __device__ __forceinline__ int lds_byte(int r, int c) { const int st = (r >> 4) * 2 + (c >> 5), rr = r & 15, cc = c & 31, ob = rr * 64 + cc * 2; return st * 1024 + (ob ^ (((ob >> 9) & 1) << 5)); }
__host__ __device__ __forceinline__ void stage_rc(int b, int& R, int& C) { const int st = b / 1024, sb = b % 1024, swz = sb ^ (((sb >> 9) & 1) << 5); R = (st >> 1) * 16 + swz / 64; C = (st & 1) * 32 + (swz % 64) / 2; }
__host__ __device__ __forceinline__ int perm32(int rho) { const int n = rho >> 4, i = rho & 15; return 8 * (i >> 2) + 4 * n + (i & 3); }
struct Unit { int pm, pn, k0, nt, part; };
struct Gemm { const bf16_t* A; int lda; const bf16_t* Bt; int M, N, K; };
struct StaticOrder {
    int nM, nN, nwg, G, c, ntk;
    __device__ __forceinline__ void init(int M, int N, int G_, int c_, int ntk_) { nM = M / BM; nN = N / BM; nwg = nM * nN; G = G_; c = c_; ntk = ntk_; }
    __device__ __forceinline__ Unit next(int i) const {
        Unit u; u.pm = -1; u.pn = 0; u.k0 = 0; u.nt = ntk; u.part = 0;
        const long L = (long)i * G + c; if (L >= nwg) return u;
        int wgid = (int)L; { const int q = nwg / NXCD, r = nwg % NXCD, xcd = wgid % NXCD, off = wgid / NXCD; wgid = (xcd < r ? xcd * (q + 1) : r * (q + 1) + (xcd - r) * q) + off; }
        const int nig = WGM * nN, gid = wgid / nig, fm = gid * WGM, gsz = (nM - fm) < WGM ? (nM - fm) : WGM;
        u.pm = fm + ((wgid % nig) % gsz); u.pn = (wgid % nig) / gsz; return u;
    }
};
struct BalancedOrder {
    StaticOrder so; bool bal; int c;
    __device__ __forceinline__ void init(int M, int N, int G_, int c_, int ntk_) { so.init(M, N, G_, c_, ntk_); c = c_; bal = (G_ == 256 && M == 40960 && N == 1024 && (ntk_ & 3) == 0); }
    __device__ __forceinline__ Unit next(int i) const {
        if (!bal) return so.next(i);
        const int xcd = c & 7, r = c >> 3, tile = r >> 1, half = so.ntk >> 1;
        Unit u;
        u.pm = i < 2 ? (i * 8 + xcd) * 8 + (r >> 2) : (i == 2 ? 128 + xcd * 4 + (tile >> 2) : -1);
        u.pn = i < 2 ? (r & 3) : (tile & 3);
        u.part = i < 2 ? 0 : (r & 1);
        u.nt = i < 2 ? so.ntk : half;
        u.k0 = i < 2 ? 0 : (r & 1) * half;
        return u;
    }
};

template <class Epi, class Sched>
__device__ __forceinline__ void gemm_phase(LAS unsigned char* lds, const Gemm g, const Sched& S, const Epi& E, const int tid) {
    const int wid = __builtin_amdgcn_readfirstlane(tid >> 6), lane = tid & 63, wr = wid >> 2, wc = wid & 3, fr = lane & 15, fq = lane >> 4;
    const int K = g.K, lda = g.lda;
    unsigned voffA[2], voffB[2];
#pragma unroll
    for (int i = 0; i < 2; ++i) { int R, C; stage_rc(tid * 16 + i * 8192, R, C); const int Rb = Epi::PERM ? ((R & ~31) + perm32(R & 31)) : R;
        voffA[i] = (unsigned)(R * lda + C) * 2u; voffB[i] = (unsigned)(Rb * K + C) * 2u; }
    const size_t kstep = (size_t)(BK * 2);
    const size_t hstepA = (size_t)HALF * lda * 2, hstepB = (size_t)HALF * K * 2;
    const size_t tstepA = 2 * hstepA, tstepB = 2 * hstepB;
    const unsigned ldsw = (unsigned)wid * 1024u;
    const int aoff = lds_byte(wr * 64 + fr, fq * 8), boff = lds_byte(wc * 32 + fr, fq * 8);
#define PG8_SA(b, h) (((b) * 2 + (h)) * HTB)
#define PG8_SB(b, h) ((4 + (b) * 2 + (h)) * HTB)
#define PG8_STAGE(bufoff, gbase, voff) do { _Pragma("unroll") for (int _i = 0; _i < 2; ++_i) { \
        const int _m0 = __builtin_amdgcn_readfirstlane((int)(unsigned long)(lds + (bufoff) + ldsw + _i * 8192));     \
        asm volatile("s_mov_b32 m0, %2\n\tglobal_load_lds_dwordx4 %0, %1" :: "v"((voff)[_i]), "s"((const char*)(gbase)), "s"(_m0) : "memory", "m0"); } } while (0)
#define PG8_LDA(dst, b, h) do { _Pragma("unroll") for (int m = 0; m < 4; ++m) _Pragma("unroll") for (int k = 0; k < 2; ++k) dst[m][k] = *(const LAS bf16x8*)(lds + PG8_SA(b, h) + aoff + m * 2048 + k * 1024); } while (0)
#define PG8_LDB(dst, b, h) do { _Pragma("unroll") for (int n = 0; n < 2; ++n) _Pragma("unroll") for (int k = 0; k < 2; ++k) dst[n][k] = *(const LAS bf16x8*)(lds + PG8_SB(b, h) + boff + n * 2048 + k * 1024); } while (0)
#define PG8_MMA(ai, bj, At, Bt) do { __builtin_amdgcn_s_setprio(1); _Pragma("unroll") for (int m = 0; m < 4; ++m) _Pragma("unroll") for (int n = 0; n < 2; ++n) _Pragma("unroll") for (int k = 0; k < 2; ++k) \
        acc[ai][bj][m][n] = __builtin_amdgcn_mfma_f32_16x16x32_bf16(Bt[n][k], At[m][k], acc[ai][bj][m][n], 0, 0, 0); __builtin_amdgcn_s_setprio(0); } while (0)
#define PG8_WAIT_V(n) asm volatile("s_waitcnt vmcnt(" #n ")" ::: "memory")
#define PG8_WAIT_L(n) asm volatile("s_waitcnt lgkmcnt(" #n ")" ::: "memory")
#define PG8_BAR __builtin_amdgcn_s_barrier()
#define PG8_SCHED __builtin_amdgcn_sched_barrier(0)
    Unit cur = S.next(0), nxt; int ui = 0;
    if (cur.pm < 0) return;
    f32x4 acc[2][2][4][2];
#pragma unroll
    for (int a = 0; a < 2; ++a)
#pragma unroll
        for (int b = 0; b < 2; ++b)
#pragma unroll
            for (int m = 0; m < 4; ++m)
#pragma unroll
                for (int n = 0; n < 2; ++n) acc[a][b][m][n] = (f32x4){0.f, 0.f, 0.f, 0.f};
    bf16x8 At[4][2], B0[2][2], B1[2][2];
    const char* cA = (const char*)g.A + (size_t)cur.pm * tstepA + (size_t)cur.k0 * kstep; const char* cB = (const char*)g.Bt + (size_t)cur.pn * tstepB + (size_t)cur.k0 * kstep;
    PG8_STAGE(PG8_SB(0, 0), cB, voffB); PG8_STAGE(PG8_SA(0, 0), cA, voffA); PG8_STAGE(PG8_SB(0, 1), cB + hstepB, voffB); PG8_STAGE(PG8_SA(0, 1), cA + hstepA, voffA);
    if (wr == 1) PG8_BAR;
    PG8_WAIT_V(4); PG8_BAR;
    PG8_STAGE(PG8_SB(1, 0), cB + kstep, voffB); PG8_STAGE(PG8_SA(1, 0), cA + kstep, voffA); PG8_STAGE(PG8_SB(1, 1), cB + hstepB + kstep, voffB);
    PG8_WAIT_V(6); PG8_BAR;
    for (;;) {
        nxt = S.next(ui + 1);
        const bool has_next = nxt.pm >= 0;
        const char* nA = has_next ? (const char*)g.A + (size_t)nxt.pm * tstepA + (size_t)nxt.k0 * kstep : cA; const char* nB = has_next ? (const char*)g.Bt + (size_t)nxt.pn * tstepB + (size_t)nxt.k0 * kstep : cB;
        const int nt = cur.nt;
        for (int t = 0; t < nt; t += 2) {
            const bool last = (t == nt - 2);
            const char* a1 = cA + (size_t)(t + 1) * kstep;
            const char* a2 = last ? nA : cA + (size_t)(t + 2) * kstep; const char* b2 = last ? nB : cB + (size_t)(t + 2) * kstep;
            const char* a3 = a2 + kstep; const char* b3 = b2 + kstep;
            if constexpr (Epi::HAS_MID) { if (t == (nt >> 1)) { int fr2 = fr, fq2 = fq; asm volatile("" : "+v"(fr2), "+v"(fq2)); E.mid(acc, cur, wr, wc, fr2, fq2); } }
            PG8_LDB(B0, 0, 0); PG8_SCHED; PG8_LDA(At, 0, 0); PG8_STAGE(PG8_SA(1, 1), a1 + hstepA, voffA);
            PG8_WAIT_L(8); PG8_BAR; PG8_MMA(0, 0, At, B0); PG8_BAR; PG8_SCHED;
            PG8_LDB(B1, 0, 1); PG8_STAGE(PG8_SB(0, 0), b2, voffB);
            PG8_WAIT_V(10); PG8_BAR; PG8_MMA(0, 1, At, B1); PG8_BAR;
            PG8_LDA(At, 0, 1); PG8_STAGE(PG8_SA(0, 0), a2, voffA);
            PG8_BAR; PG8_MMA(1, 0, At, B0); PG8_BAR; PG8_SCHED;
            PG8_STAGE(PG8_SB(0, 1), b2 + hstepB, voffB);
            PG8_WAIT_V(8); PG8_BAR; PG8_MMA(1, 1, At, B1); PG8_BAR;
            PG8_LDB(B0, 1, 0); PG8_SCHED; PG8_LDA(At, 1, 0); PG8_STAGE(PG8_SA(0, 1), a2 + hstepA, voffA);
            PG8_WAIT_L(8); PG8_BAR; PG8_MMA(0, 0, At, B0); PG8_BAR; PG8_SCHED;
            PG8_LDB(B1, 1, 1); PG8_STAGE(PG8_SB(1, 0), b3, voffB);
            PG8_WAIT_V(10); PG8_BAR; PG8_MMA(0, 1, At, B1); PG8_BAR;
            PG8_LDA(At, 1, 1); PG8_STAGE(PG8_SA(1, 0), a3, voffA);
            PG8_BAR; PG8_MMA(1, 0, At, B0); PG8_BAR; PG8_SCHED;
            PG8_STAGE(PG8_SB(1, 1), b3 + hstepB, voffB);
            PG8_WAIT_V(8); PG8_BAR; PG8_MMA(1, 1, At, B1); PG8_BAR;
        }
        for (int er = 0; er < (Epi::HAS_MID ? 1 : EPI_REP); ++er) { int fr2 = fr, fq2 = fq; asm volatile("" : "+v"(fr2), "+v"(fq2)); E(acc, cur, wr, wc, fr2, fq2); }
        if (!has_next) break;
#pragma unroll
        for (int a = 0; a < 2; ++a)
#pragma unroll
            for (int b = 0; b < 2; ++b)
#pragma unroll
                for (int m = 0; m < 4; ++m)
#pragma unroll
                    for (int n = 0; n < 2; ++n) acc[a][b][m][n] = (f32x4){0.f, 0.f, 0.f, 0.f};
        cur = nxt; cA = nA; cB = nB; ++ui;
    }
    PG8_WAIT_V(0);
    if (wr == 0) PG8_BAR;
    PG8_BAR;
#undef PG8_SA
#undef PG8_SB
#undef PG8_STAGE
#undef PG8_LDA
#undef PG8_LDB
#undef PG8_MMA
#undef PG8_WAIT_V
#undef PG8_WAIT_L
#undef PG8_BAR
#undef PG8_SCHED
}
}
using pg8::Unit;
typedef f32x4 AccT[2][2][4][2];

struct EpiSwiGLU {
    static constexpr bool PERM = true, HAS_MID = false;
    bf16_t* H;
    __device__ __forceinline__ void operator()(const AccT& acc, const Unit& u, int wr, int wc, int fr, int fq) const {
        const int row0 = u.pm * 256 + wr * 64 + fr, col0 = u.pn * 128 + wc * 32 + 8 * fq;
#pragma unroll
        for (int ai = 0; ai < 2; ++ai)
#pragma unroll
            for (int m = 0; m < 4; ++m) {
                bf16_t* rowp = H + (size_t)(row0 + ai * 128 + m * 16) * DFF + col0;
                float h[8];
#pragma unroll
                for (int n = 0; n < 2; ++n)
#pragma unroll
                    for (int j = 0; j < 4; ++j) { const float gt = acc[ai][0][m][n][j], up = acc[ai][1][m][n][j]; h[n * 4 + j] = gt * sigm(gt) * up; }
                u32x4 w; w.x = cvt_pk_bf16(h[0], h[1]); w.y = cvt_pk_bf16(h[2], h[3]); w.z = cvt_pk_bf16(h[4], h[5]); w.w = cvt_pk_bf16(h[6], h[7]);
                *(u32x4*)rowp = w;
            }
    }
};
template <bool ACC>
struct EpiDelta {
    static constexpr bool PERM = true, HAS_MID = false;
    bf16_t* D; const bf16_t* Din; const float* modg; float scale; bf16_t* D2;
    __device__ __forceinline__ void operator()(const AccT& acc, const Unit& u, int wr, int wc, int fr, int fq) const {
        const int row0 = u.pm * 256 + wr * 64 + fr, col0 = u.pn * 256 + wc * 32 + 8 * fq;
        const bool side = u.part != 0;
        const long long dofs = side ? (long long)(D2 - D) : 0ll;
        const float* gp = modg + (size_t)modrow_of(u.pm * 256) * NMODC + col0;
        f32x4 gv[2][2];
#pragma unroll
        for (int bj = 0; bj < 2; ++bj)
#pragma unroll
            for (int n = 0; n < 2; ++n) gv[bj][n] = *(const f32x4*)(gp + bj * 128 + n * 4) * scale;
#pragma unroll
        for (int ai = 0; ai < 2; ++ai) {
            u32x4 q[4][2];
            if (ACC && !side) {
#pragma unroll
                for (int m = 0; m < 4; ++m)
#pragma unroll
                    for (int bj = 0; bj < 2; ++bj) q[m][bj] = *(const u32x4*)(Din + (size_t)(row0 + ai * 128 + m * 16) * DM + col0 + bj * 128);
            }
#pragma unroll
            for (int m = 0; m < 4; ++m) {
                bf16_t* rowp = D + dofs + (size_t)(row0 + ai * 128 + m * 16) * DM + col0;
#pragma unroll
                for (int bj = 0; bj < 2; ++bj) { f32x4 v0 = acc[ai][bj][m][0] * gv[bj][0], v1 = acc[ai][bj][m][1] * gv[bj][1];
                    if (ACC && !side) { const u32x4 g = q[m][bj]; v0 += (f32x4){bflo(g.x), bfhi(g.x), bflo(g.y), bfhi(g.y)}; v1 += (f32x4){bflo(g.z), bfhi(g.z), bflo(g.w), bfhi(g.w)}; }
                    u32x4 w; w.x = cvt_pk_bf16(v0[0], v0[1]); w.y = cvt_pk_bf16(v0[2], v0[3]); w.z = cvt_pk_bf16(v1[0], v1[1]); w.w = cvt_pk_bf16(v1[2], v1[3]);
                    *(u32x4*)(rowp + bj * 128) = w; }
            }
        }
    }
};
struct EpiZ {
    static constexpr bool PERM = true, HAS_MID = false;
    bf16_t* Z; float* VSS;
    __device__ __forceinline__ void operator()(const AccT& acc, const Unit& u, int wr, int wc, int fr, int fq) const {
        const int sec = u.pn >> 2;
        const int row0 = u.pm * 256 + wr * 64 + fr, col0 = u.pn * 256 + wc * 32 + 8 * fq;
#pragma unroll
        for (int ai = 0; ai < 2; ++ai)
#pragma unroll
            for (int m = 0; m < 4; ++m) {
                const int row = row0 + ai * 128 + m * 16;
                bf16_t* rowp = Z + (size_t)row * 4096 + col0;
                float ss = 0.f;
#pragma unroll
                for (int bj = 0; bj < 2; ++bj) {
                    float v[8];
#pragma unroll
                    for (int n = 0; n < 2; ++n)
#pragma unroll
                        for (int j = 0; j < 4; ++j) { float x = acc[ai][bj][m][n][j]; if (sec) x = gelu_t(x); v[n * 4 + j] = x; ss += x * x; }
                    u32x4 w; w.x = cvt_pk_bf16(v[0], v[1]); w.y = cvt_pk_bf16(v[2], v[3]); w.z = cvt_pk_bf16(v[4], v[5]); w.w = cvt_pk_bf16(v[6], v[7]);
                    *(u32x4*)(rowp + bj * 128) = w;
                }
                if (sec == 3) { ss += __shfl_xor(ss, 16); ss += __shfl_xor(ss, 32); if (fq == 0) VSS[(size_t)row * 16 + (u.pn - 12) * 4 + wc] = ss; }
            }
    }
};
struct EpiGates {
    static constexpr bool PERM = true, HAS_MID = false;
    bf16_t* Z;
    __device__ __forceinline__ void operator()(const AccT& acc, const Unit& u, int wr, int wc, int fr, int fq) const {
        const int row0 = u.pm * 256 + wr * 64 + fr, col0 = u.pn * 128 + wc * 32 + 8 * fq;
#pragma unroll
        for (int ai = 0; ai < 2; ++ai)
#pragma unroll
            for (int m = 0; m < 4; ++m) {
                bf16_t* rowp = Z + (size_t)(row0 + ai * 128 + m * 16) * 4096 + col0;
                float rt[8], sb[8];
#pragma unroll
                for (int n = 0; n < 2; ++n)
#pragma unroll
                    for (int j = 0; j < 4; ++j) {
                        const float ea = __builtin_amdgcn_exp2f(__builtin_amdgcn_fmed3f(-1.4426950408889634f * acc[ai][0][m][n][j], -3.0e38f, 80.f));
                        const float eb = __builtin_amdgcn_exp2f(__builtin_amdgcn_fmed3f(-1.4426950408889634f * acc[ai][1][m][n][j], -3.0e38f, 80.f));
                        rt[n * 4 + j] = (1.0f + eb) * __builtin_amdgcn_rcpf(1.0f + ea); sb[n * 4 + j] = __builtin_amdgcn_rcpf(1.0f + eb); }
                u32x4 w; w.x = cvt_pk_bf16(rt[0], rt[1]); w.y = cvt_pk_bf16(rt[2], rt[3]); w.z = cvt_pk_bf16(rt[4], rt[5]); w.w = cvt_pk_bf16(rt[6], rt[7]);
                *(u32x4*)rowp = w;
                w.x = cvt_pk_bf16(sb[0], sb[1]); w.y = cvt_pk_bf16(sb[2], sb[3]); w.z = cvt_pk_bf16(sb[4], sb[5]); w.w = cvt_pk_bf16(sb[6], sb[7]);
                *(u32x4*)(rowp + 3072) = w;
            }
    }
};
struct EpiMerge {
    static constexpr bool PERM = true, HAS_MID = true;
    const bf16_t* Z; bf16_t* O;
    __device__ __forceinline__ void scale(AccT& acc, const Unit& u, int wr, int wc, int fr, int fq, int zoff) const {
        const int row0 = u.pm * 256 + wr * 64 + fr, col0 = u.pn * 256 + wc * 32 + 8 * fq;
        u32x4 q[2][4][2];
#pragma unroll
        for (int ai = 0; ai < 2; ++ai)
#pragma unroll
            for (int m = 0; m < 4; ++m)
#pragma unroll
                for (int bj = 0; bj < 2; ++bj) q[ai][m][bj] = *(const u32x4*)(Z + (size_t)(row0 + ai * 128 + m * 16) * 4096 + zoff + col0 + bj * 128);
#pragma unroll
        for (int ai = 0; ai < 2; ++ai)
#pragma unroll
            for (int m = 0; m < 4; ++m)
#pragma unroll
                for (int bj = 0; bj < 2; ++bj) { const u32x4 g = q[ai][m][bj];
                    acc[ai][bj][m][0] *= (f32x4){bflo(g.x), bfhi(g.x), bflo(g.y), bfhi(g.y)};
                    acc[ai][bj][m][1] *= (f32x4){bflo(g.z), bfhi(g.z), bflo(g.w), bfhi(g.w)}; }
    }
    __device__ __forceinline__ void mid(AccT& acc, const Unit& u, int wr, int wc, int fr, int fq) const { scale(acc, u, wr, wc, fr, fq, 0); }
    __device__ __forceinline__ void operator()(AccT& acc, const Unit& u, int wr, int wc, int fr, int fq) const {
        scale(acc, u, wr, wc, fr, fq, 3072);
        const int row0 = u.pm * 256 + wr * 64 + fr, col0 = u.pn * 256 + wc * 32 + 8 * fq;
#pragma unroll
        for (int ai = 0; ai < 2; ++ai)
#pragma unroll
            for (int m = 0; m < 4; ++m) {
                bf16_t* op = O + (size_t)(row0 + ai * 128 + m * 16) * DM + col0;
#pragma unroll
                for (int bj = 0; bj < 2; ++bj) { const f32x4 v0 = acc[ai][bj][m][0], v1 = acc[ai][bj][m][1];
                    u32x4 w; w.x = cvt_pk_bf16(v0[0], v0[1]); w.y = cvt_pk_bf16(v0[2], v0[3]); w.z = cvt_pk_bf16(v1[0], v1[1]); w.w = cvt_pk_bf16(v1[2], v1[3]);
                    *(u32x4*)(op + bj * 128) = w; }
            }
    }
};

__device__ __forceinline__ void transpose_tile(const float* __restrict__ src, int ldsrc, int k0, int n0, bf16_t* dst, int lddst, int drow0, int dcol0, float* tile, const int tid) {
#pragma unroll
    for (int i = 0; i < 2; ++i) { const int e = tid + i * 512, kr = e >> 4, c4 = (e & 15) * 4;
        const f32x4 v = *(const f32x4*)(src + (size_t)(k0 + kr) * ldsrc + n0 + c4);
        float* tp = tile + kr * 65 + c4; tp[0] = v[0]; tp[1] = v[1]; tp[2] = v[2]; tp[3] = v[3]; }
    __syncthreads();
    const int nr = tid >> 3, kg = (tid & 7) * 8;
    float v[8];
#pragma unroll
    for (int j = 0; j < 8; ++j) v[j] = tile[(kg + j) * 65 + nr];
    u32x4 w; w.x = cvt_pk_bf16(v[0], v[1]); w.y = cvt_pk_bf16(v[2], v[3]); w.z = cvt_pk_bf16(v[4], v[5]); w.w = cvt_pk_bf16(v[6], v[7]);
    *(u32x4*)(dst + (size_t)(drow0 + nr) * lddst + dcol0 + kg) = w;
    __syncthreads();
}

__device__ __forceinline__ void transpose_range(unsigned char* wsb, unsigned char* shm, const int tid, const int wg, const int nwg, const int nv, const int mode) {
    const float* const* pt = (const float* const*)(wsb + WS_PTAB);
    auto vmap = [&](int v) { return mode == 0 ? (v < 2112 ? v : v + 2112) : (mode == 1 ? 1408 + v : (mode == 2 ? 2112 + v : v)); };
    float* tile = (float*)shm;
    const int G = nwg; const int bid = wg;
    struct TJob { const float* src; bf16_t* dst; int ldsrc, lddst; };
    auto job_of = [&](int ti, TJob& j) {
        int k0, n0, drow, dcol;
        if (ti < 4224) {
            const int f = ti / 2112, r = ti % 2112, kind = r / 704, tt = r % 704;
            if (kind < 2) { const int kt = tt / 44, ntile = tt % 44; n0 = ntile * 64; k0 = kt * 64;
                j.src = pt[f * 3 + kind]; j.ldsrc = DFF;
                j.dst = (bf16_t*)(wsb + (f ? WS_FF2 : WS_FF1)); j.lddst = 1024; drow = 256 * (n0 >> 7) + (n0 & 127) + (kind ? 128 : 0); dcol = k0;
            } else { const int kt = tt / 16, ntile = tt % 16; n0 = ntile * 64; k0 = kt * 64;
                j.src = pt[f * 3 + 2]; j.ldsrc = 1024; j.dst = (bf16_t*)(wsb + (f ? WS_FF2D : WS_FF1D)); j.lddst = DFF; drow = n0; dcol = k0; }
        } else if (ti < 5760) { const int tt = ti - 4224, kt = tt / 96, ntile = tt % 96; n0 = ntile * 64; k0 = kt * 64;
            const int cc = (n0 - 4096) & 1023;
            j.src = pt[6]; j.ldsrc = 6144; j.dst = (bf16_t*)(wsb + WS_IN); j.lddst = 1024; dcol = k0;
            drow = n0 < 4096 ? n0 : 4096 + 256 * (cc >> 7) + (cc & 127) + (n0 >= 5120 ? 128 : 0);
        } else { const int tt = ti - 5760, which = tt >> 8, r = tt & 255, kt = r >> 4, ntile = r & 15; n0 = ntile * 64; k0 = kt * 64;
            j.src = pt[7 + which]; j.ldsrc = 1024; drow = n0;
            if (which < 2) { j.dst = (bf16_t*)(wsb + WS_CAT); j.lddst = 2048; dcol = which * 1024 + k0; } else { j.dst = (bf16_t*)(wsb + WS_OUT); j.lddst = 1024; dcol = k0; }
        }
        j.src += (size_t)k0 * j.ldsrc + n0; j.dst += (size_t)drow * j.lddst + dcol;
    };
    {
        TJob cur[2], nxt[2]; f32x4 ld[2][2];
        float* tile2 = tile + 64 * 65;
        int ti = bid * 2;
        auto issue = [&](int t0, TJob (&jb)[2]) {
#pragma unroll
            for (int h = 0; h < 2; ++h) if (t0 + h < nv) { job_of(vmap(t0 + h), jb[h]);
#pragma unroll
                for (int i = 0; i < 2; ++i) { const int e = tid + i * 512; ld[h][i] = *(const f32x4*)(jb[h].src + (size_t)(e >> 4) * jb[h].ldsrc + (e & 15) * 4); } }
        };
        if (ti < nv) issue(ti, cur);
        for (; ti < nv; ti += 2 * G) {
#pragma unroll
            for (int h = 0; h < 2; ++h) if (ti + h < nv) {
#pragma unroll
                for (int i = 0; i < 2; ++i) { const int e = tid + i * 512; float* tp = (h ? tile2 : tile) + (e >> 4) * 65 + (e & 15) * 4; tp[0] = ld[h][i][0]; tp[1] = ld[h][i][1]; tp[2] = ld[h][i][2]; tp[3] = ld[h][i][3]; } }
            __syncthreads();
            const bool more = ti + 2 * G < nv;
            if (more) issue(ti + 2 * G, nxt);
            const int nr = tid >> 3, kg = (tid & 7) * 8;
#pragma unroll
            for (int h = 0; h < 2; ++h) if (ti + h < nv) {
                const float* tb = h ? tile2 : tile;
                float v[8];
#pragma unroll
                for (int jj = 0; jj < 8; ++jj) v[jj] = tb[(kg + jj) * 65 + nr];
                u32x4 w; w.x = cvt_pk_bf16(v[0], v[1]); w.y = cvt_pk_bf16(v[2], v[3]); w.z = cvt_pk_bf16(v[4], v[5]); w.w = cvt_pk_bf16(v[6], v[7]);
                *(u32x4*)(cur[h].dst + (size_t)nr * cur[h].lddst + kg) = w; }
            __syncthreads();
            if (more) { cur[0] = nxt[0]; cur[1] = nxt[1]; }
        }
    }
}

__device__ __forceinline__ void prep_phase(const Params& p, unsigned char* shm, const int tid, const int bid) {
    const int G = gridDim.x;
    for (int item = bid; item < 144; item += G) {
        float* scond = (float*)shm; float* red = (float*)(shm + 36864);
        for (int e = tid; e < 9216; e += 512) { const int b = e >> 10, k = e & 1023; const float cv = b < 8 ? p.c[b * 1024 + k] : p.c_ctx[k]; scond[e] = cv / (1.0f + __expf(-cv)); }
        __syncthreads();
        const int n0 = item * 64, cl = tid & 63, kg = tid >> 6;
        float acc[9];
#pragma unroll
        for (int b = 0; b < 9; ++b) acc[b] = 0.f;
        const float* wp = p.w_mod + (size_t)(kg * 128) * NMODC + n0 + cl;
#pragma unroll 16
        for (int k = 0; k < 128; ++k) { const float wv = wp[(size_t)k * NMODC];
#pragma unroll
            for (int b = 0; b < 9; ++b) acc[b] += scond[b * 1024 + kg * 128 + k] * wv; }
#pragma unroll
        for (int b = 0; b < 9; ++b) red[(kg * 9 + b) * 64 + cl] = acc[b];
        __syncthreads();
        float* MOD = (float*)(p.ws + WS_MOD);
        for (int e = tid; e < 576; e += 512) { const int b = e >> 6, cc = e & 63; float s = p.b_mod[n0 + cc];
#pragma unroll
            for (int k2 = 0; k2 < 8; ++k2) s += red[(k2 * 9 + b) * 64 + cc];
            MOD[b * NMODC + n0 + cc] = s; }
        __syncthreads();
    }
    if (tid == 0) { const float** ptw = (const float**)(p.ws + WS_PTAB);
        ptw[0] = p.ff1_gate; ptw[1] = p.ff1_up; ptw[2] = p.ff1_down; ptw[3] = p.ff2_gate; ptw[4] = p.ff2_up; ptw[5] = p.ff2_down; ptw[6] = p.w_in; ptw[7] = p.w_br; ptw[8] = p.w_bg; ptw[9] = p.w_out; }
    __syncthreads();
    if (G == 256) transpose_range(p.ws, shm, tid, bid, G, 4416, 0); else transpose_range(p.ws, shm, tid, bid, G, 6528, 3);
    const int gt = bid * 512 + tid, GT = G * 512;
    for (int idx = gt; idx < 32768; idx += GT) {
        const int lane = idx & 63, ks = (idx >> 6) & 3, cb = (idx >> 8) & 1, head = (idx >> 9) & 15, gate = (idx >> 13) & 1, dir = idx >> 14;
        const float* src = (gate ? p.w_i : p.w_r) + (size_t)((dir * 16 + head) * 64) * 64;
        const int i0 = 8 * (lane >> 5) + 16 * ks, j = (lane & 31) + 32 * cb;
        float v[8];
#pragma unroll
        for (int jj = 0; jj < 8; ++jj) v[jj] = -1.4426950408889634f * src[(i0 + jj) * 64 + j];
        u32x4 w; w.x = cvt_pk_bf16(v[0], v[1]); w.y = cvt_pk_bf16(v[2], v[3]); w.z = cvt_pk_bf16(v[4], v[5]); w.w = cvt_pk_bf16(v[6], v[7]);
        *(u32x4*)(p.ws + WS_WG + (size_t)idx * 16) = w;
    }
    for (int idx = gt; idx < 16384; idx += GT) {
        const f32x4 a = *(const f32x4*)(p.w_s + (size_t)idx * 8), b = *(const f32x4*)(p.w_s + (size_t)idx * 8 + 4);
        u32x4 w; w.x = cvt_pk_bf16(a[0], a[1]); w.y = cvt_pk_bf16(a[2], a[3]); w.z = cvt_pk_bf16(b[0], b[1]); w.w = cvt_pk_bf16(b[2], b[3]);
        *(u32x4*)(p.ws + WS_WS + (size_t)idx * 16) = w;
    }
    float* PE = (float*)(p.ws + WS_PE);
    for (int idx = gt; idx < 32768; idx += GT) {
        const int pos = idx >> 9, jc = idx & 511, j = jc & 255;
        const float freq = 1.0f / powf(10000.0f, (float)j / 256.0f);
        const float ang = (float)pos * freq;
        PE[idx] = jc < 256 ? sinf(ang) : cosf(ang);
    }
}

template <int MODE>
__device__ __forceinline__ void norm_phase(const Params& p, const bf16_t* delta, bf16_t* dsum_wb, const int tid, const int bid) {
    const bf16_t* D2 = (const bf16_t*)(p.ws + WS_D2);
    constexpr int NR = 4;
    const int lane = tid & 63, wv = tid >> 6;
    const int gw = bid * 8 + wv, nw = gridDim.x * 8;
    const float* PE = (const float*)(p.ws + WS_PE);
    const float* MOD = (const float*)(p.ws + WS_MOD);
    bf16_t* HM = (bf16_t*)(p.ws + WS_HMOD);
    const float* gvec = MODE == 1 ? p.norm1 : (MODE == 2 ? p.norm2 : (MODE == 3 ? p.norm3 : p.norm_f));
    f32x4 gn[4];
#pragma unroll
    for (int i = 0; i < 4; ++i) gn[i] = *(const f32x4*)(gvec + lane * 4 + 256 * i);
    for (int row0 = gw * NR; row0 < MTOK; row0 += nw * NR) {
        f32x4 v[NR][4]; u32x2 dq[NR][4];
#pragma unroll
        for (int r = 0; r < NR; ++r) {
            const int row = row0 + r;
            const float* src = row < MCTX ? p.x_prompt + (size_t)row * DM : p.x_sample + (size_t)(row - MCTX) * DM;
#pragma unroll
            for (int i = 0; i < 4; ++i) v[r][i] = __builtin_nontemporal_load((const f32x4*)(src + lane * 4 + 256 * i));
            if (MODE != 1) {
#pragma unroll
                for (int i = 0; i < 4; ++i) dq[r][i] = __builtin_nontemporal_load((const u32x2*)(delta + (size_t)row * DM + lane * 4 + 256 * i));
            }
        }
        if (row0 >= MCTX) {
#pragma unroll
            for (int r = 0; r < NR; ++r) { const int pos = (row0 + r - MCTX) & 4095, pr = pos >> 6, pc = pos & 63;
#pragma unroll
                for (int i = 0; i < 4; ++i) { const int col = lane * 4 + 256 * i; v[r][i] += *(const f32x4*)(PE + (i < 2 ? pr : pc) * 512 + (col & 511)); } }
        }
        if (MODE != 1 && row0 >= SPLIT_ROW0) {
#pragma unroll
            for (int r = 0; r < NR; ++r)
#pragma unroll
                for (int i = 0; i < 4; ++i) { const u32x2 e = __builtin_nontemporal_load((const u32x2*)(D2 + (size_t)(row0 + r) * DM + lane * 4 + 256 * i));
                    const f32x4 t = (f32x4){bflo(dq[r][i].x), bfhi(dq[r][i].x), bflo(dq[r][i].y), bfhi(dq[r][i].y)} + (f32x4){bflo(e.x), bfhi(e.x), bflo(e.y), bfhi(e.y)};
                    dq[r][i].x = cvt_pk_bf16(t[0], t[1]); dq[r][i].y = cvt_pk_bf16(t[2], t[3]);
                    if (dsum_wb) *(u32x2*)(dsum_wb + (size_t)(row0 + r) * DM + lane * 4 + 256 * i) = dq[r][i]; }
        }
        const float* mp = MOD + (size_t)modrow_of(row0) * NMODC + (MODE - 1) * 3 * 1024;
#pragma unroll
        for (int r = 0; r < NR; ++r) {
            const int row = row0 + r;
            float* orow = p.out + (size_t)row * DM;
            if (MODE != 1) {
#pragma unroll
                for (int i = 0; i < 4; ++i) v[r][i] += (f32x4){bflo(dq[r][i].x), bfhi(dq[r][i].x), bflo(dq[r][i].y), bfhi(dq[r][i].y)};
            }
            float ss = 0.f;
#pragma unroll
            for (int i = 0; i < 4; ++i) ss += v[r][i][0] * v[r][i][0] + v[r][i][1] * v[r][i][1] + v[r][i][2] * v[r][i][2] + v[r][i][3] * v[r][i][3];
#pragma unroll
            for (int o = 32; o >= 1; o >>= 1) ss += __shfl_xor(ss, o);
            const float rstd = __builtin_amdgcn_rsqf(ss * (1.0f / 1024.0f) + 1e-6f);
            if (MODE == 4) {
#pragma unroll
                for (int i = 0; i < 4; ++i) __builtin_nontemporal_store(v[r][i] * rstd * gn[i], (f32x4*)(orow + lane * 4 + 256 * i));
            } else {
#pragma unroll
                for (int i = 0; i < 4; ++i) { const int col = lane * 4 + 256 * i;
                    const f32x4 sh = *(const f32x4*)(mp + col), sc = *(const f32x4*)(mp + 1024 + col);
                    const f32x4 h = v[r][i] * rstd * gn[i] * (sc + 1.0f) + sh;
                    u32x2 w; w.x = cvt_pk_bf16(h[0], h[1]); w.y = cvt_pk_bf16(h[2], h[3]);
                    *(u32x2*)(HM + (size_t)row * DM + col) = w; }
            }
        }
    }
}

template <bool PASS2>
__device__ __forceinline__ void scan_phase(const Params& p, unsigned char* shm, const int tid, const int bid) {
    LAS bf16_t* Xc = (LAS bf16_t*)((LAS unsigned char*)shm);
    LAS bf16_t* Hf = (LAS bf16_t*)((LAS unsigned char*)shm + 36864);
    LAS bf16_t* Hb = (LAS bf16_t*)((LAS unsigned char*)shm + 36864 + 32768);
    const int lane = tid & 63, w = tid >> 6;
    const int dir = w & 1, cb = (w >> 1) & 1, hsel = w >> 2, hh = lane >> 5, l31 = lane & 31;
    const int G8 = gridDim.x >> 3, hp = bid & 7;
    bf16_t* Z = (bf16_t*)(p.ws + WS_Z);
    float* SUMA = (float*)(p.ws + WS_SUMA); float* SUMB = (float*)(p.ws + WS_SUMB);
    const int cg8 = tid & 15, tq = tid >> 4, c0 = hp * 128 + cg8 * 8;
    LAS float* CW = (LAS float*)((LAS unsigned char*)shm + 102400);
    for (int e = tid; e < 640; e += 512) CW[e] = e < 512 ? p.conv_w[(e >> 7) * 1024 + hp * 128 + (e & 127)] : p.conv_b[hp * 128 + (e & 127)];
    __syncthreads();
    const int head = hp * 2 + hsel, c = head * 64 + cb * 32 + l31;
    bf16x8 Wr[4], Wi[4];
    { const bf16x8* wg = (const bf16x8*)(p.ws + WS_WG);
#pragma unroll
        for (int ks = 0; ks < 4; ++ks) { Wr[ks] = wg[(((((dir * 2 + 0) * 16 + head) * 2 + cb) * 4 + ks) * 64) + lane]; Wi[ks] = wg[(((((dir * 2 + 1) * 16 + head) * 2 + cb) * 4 + ks) * 64) + lane]; } }
    const float brs = -1.4426950408889634f * p.b_r[dir * 1024 + c], bis = -1.4426950408889634f * p.b_i[dir * 1024 + c];
    const float lamv = p.lam[dir * 1024 + c];
    const float ls8l = 8.0f * 1.4426950408889634f * (fminf(lamv, 0.f) - log1pf(expf(-fabsf(lamv))));
    const LAS bf16_t* XcH = Xc + hsel * 128 * 72;
    LAS bf16_t* Hx = (dir ? Hb : Hf) + hsel * 128 * 64 + cb * 32 + l31;
    u32x4 rows[7];
    auto load_rows = [&](int sc) {
        int seqstart, T;
        if (sc < 64) { seqstart = (sc >> 1) * 256; T = 256; } else { seqstart = MCTX + ((sc - 64) >> 5) * 4096; T = 4096; }
        const int tok0 = sc * 128, pos0 = tok0 - seqstart;
#pragma unroll
        for (int rr = 0; rr < 7; ++rr) { const int tt = 4 * tq - 2 + rr, pp = pos0 + tt;
            rows[rr] = (pp >= 0 && pp < T) ? *(const u32x4*)(Z + (size_t)(tok0 + tt) * 4096 + c0) : (u32x4){0u, 0u, 0u, 0u}; }
    };
    int sc = bid >> 3;
    if (sc < NSC) load_rows(sc);
    for (; sc < NSC; sc += G8) {
        const int tok0 = sc * 128;
        {
            float a[4][8];
            { const f32x4 b0 = *(const LAS f32x4*)(CW + 512 + cg8 * 8), b1 = *(const LAS f32x4*)(CW + 512 + cg8 * 8 + 4);
#pragma unroll
                for (int e = 0; e < 4; ++e) { a[e][0] = b0[0]; a[e][1] = b0[1]; a[e][2] = b0[2]; a[e][3] = b0[3]; a[e][4] = b1[0]; a[e][5] = b1[1]; a[e][6] = b1[2]; a[e][7] = b1[3]; } }
#pragma unroll
            for (int k = 0; k < 4; ++k) { const f32x4 w0 = *(const LAS f32x4*)(CW + k * 128 + cg8 * 8), w1 = *(const LAS f32x4*)(CW + k * 128 + cg8 * 8 + 4);
#pragma unroll
                for (int e = 0; e < 4; ++e) { const u32x4 raw = rows[e + k];
                    a[e][0] += w0[0] * bflo(raw.x); a[e][1] += w0[1] * bfhi(raw.x); a[e][2] += w0[2] * bflo(raw.y); a[e][3] += w0[3] * bfhi(raw.y);
                    a[e][4] += w1[0] * bflo(raw.z); a[e][5] += w1[1] * bfhi(raw.z); a[e][6] += w1[2] * bflo(raw.w); a[e][7] += w1[3] * bfhi(raw.w); } }
#pragma unroll
            for (int e = 0; e < 4; ++e) { u32x4 wq; wq.x = cvt_pk_bf16(a[e][0], a[e][1]); wq.y = cvt_pk_bf16(a[e][2], a[e][3]); wq.z = cvt_pk_bf16(a[e][4], a[e][5]); wq.w = cvt_pk_bf16(a[e][6], a[e][7]);
                *(LAS u32x4*)(Xc + ((cg8 >> 3) * 128 + 4 * tq + e) * 72 + (cg8 & 7) * 8) = wq; }
        }
        __syncthreads();
        if (sc + G8 < NSC) load_rows(sc + G8);
        u32x4 ggr[4];
        if (PASS2) {
#pragma unroll
            for (int i = 0; i < 4; ++i) { const int e = tid + 512 * i; ggr[i] = *(const u32x4*)(Z + (size_t)(tok0 + (e >> 4)) * 4096 + 1024 + hp * 128 + (e & 15) * 8); }
        }
        float s = 0.f, PA = 1.f, PB = 0.f;
        if (PASS2) s = SUMB[(size_t)(dir * NSC + sc) * 1024 + c];
        auto tiles = [&](auto dirc) {
        constexpr int DIR = decltype(dirc)::value;
#pragma unroll 2
        for (int tile = 0; tile < 4; ++tile) {
            const int mA = tile * 32 + l31, tokA = DIR ? 127 - mA : mA;
            f32x16 ar, ai;
#pragma unroll
            for (int i = 0; i < 16; ++i) { ar[i] = brs; ai[i] = bis; }
#pragma unroll
            for (int ks = 0; ks < 4; ++ks) { const bf16x8 a = *(const LAS bf16x8*)(XcH + tokA * 72 + ks * 16 + hh * 8);
                ar = __builtin_amdgcn_mfma_f32_32x32x16_bf16(a, Wr[ks], ar, 0, 0, 0); ai = __builtin_amdgcn_mfma_f32_32x32x16_bf16(a, Wi[ks], ai, 0, 0, 0); }
            f32x2 a2[2][4], b2[2][4];
#pragma unroll
            for (int gp = 0; gp < 2; ++gp)
#pragma unroll
                for (int jj = 0; jj < 4; ++jj) {
                    const int i0 = 8 * gp + jj, i1 = i0 + 4;
                    const int m0 = tile * 32 + jj + 16 * gp + 4 * hh, m1 = m0 + 8, t0 = DIR ? 127 - m0 : m0, t1 = DIR ? 127 - m1 : m1;
                    const f32x2 xc = {bf2f(XcH[t0 * 72 + cb * 32 + l31]), bf2f(XcH[t1 * 72 + cb * 32 + l31])};
                    const f32x2 e1 = {__builtin_amdgcn_exp2f(__builtin_amdgcn_fmed3f(ar[i0], -3.0e38f, 60.f)), __builtin_amdgcn_exp2f(__builtin_amdgcn_fmed3f(ar[i1], -3.0e38f, 60.f))};
                    const f32x2 e2 = {__builtin_amdgcn_exp2f(__builtin_amdgcn_fmed3f(ai[i0], -3.0e38f, 60.f)), __builtin_amdgcn_exp2f(__builtin_amdgcn_fmed3f(ai[i1], -3.0e38f, 60.f))};
                    const f32x2 d1 = e1 + 1.0f, d2 = e2 + 1.0f, dd = d1 * d2;
                    const f32x2 R = {__builtin_amdgcn_rcpf(dd.x), __builtin_amdgcn_rcpf(dd.y)};
                    const f32x2 r = R * d2, ig = R * d1;
                    const f32x2 t = r * ls8l;
                    const f32x2 a = {__builtin_amdgcn_exp2f(t.x), __builtin_amdgcn_exp2f(t.y)};
                    const f32x2 om = 1.0f - a * a;
                    const f32x2 mult = {__builtin_amdgcn_sqrtf(om.x), __builtin_amdgcn_sqrtf(om.y)};
                    a2[gp][jj] = a; b2[gp][jj] = mult * ig * xc;
                }
            float gA[4], gB[4];
#pragma unroll
            for (int gp = 0; gp < 2; ++gp) { f32x2 A = a2[gp][0], B = b2[gp][0];
#pragma unroll
                for (int jj = 1; jj < 4; ++jj) { B = a2[gp][jj] * B + b2[gp][jj]; A = A * a2[gp][jj]; }
                gA[2 * gp] = A.x; gA[2 * gp + 1] = A.y; gB[2 * gp] = B.x; gB[2 * gp + 1] = B.y; }
            float st[4];
#pragma unroll
            for (int g = 0; g < 4; ++g) {
                const auto ra = __builtin_amdgcn_permlane32_swap(__float_as_uint(gA[g]), __float_as_uint(gA[g]), false, false);
                const auto rb = __builtin_amdgcn_permlane32_swap(__float_as_uint(gB[g]), __float_as_uint(gB[g]), false, false);
                const float fA = __uint_as_float(ra[0]), sA = __uint_as_float(ra[1]), fB = __uint_as_float(rb[0]), sB = __uint_as_float(rb[1]);
                if (PASS2) { const float s0 = s, s1 = fA * s0 + fB; s = sA * s1 + sB; st[g] = hh ? s1 : s0; }
                else { PB = fA * PB + fB; PA *= fA; PB = sA * PB + sB; PA *= sA; }
            }
            if (PASS2) {
#pragma unroll
                for (int gp = 0; gp < 2; ++gp) { f32x2 h = {st[2 * gp], st[2 * gp + 1]};
#pragma unroll
                    for (int jj = 0; jj < 4; ++jj) { h = a2[gp][jj] * h + b2[gp][jj];
                        const int m0 = tile * 32 + jj + 16 * gp + 4 * hh, m1 = m0 + 8, t0 = DIR ? 127 - m0 : m0, t1 = DIR ? 127 - m1 : m1;
                        const unsigned pk = cvt_pk_bf16(h.x, h.y);
                        Hx[t0 * 64] = (bf16_t)(pk & 0xffffu); Hx[t1 * 64] = (bf16_t)(pk >> 16); } }
            }
        }
        };
        if (__builtin_amdgcn_readfirstlane(dir)) tiles(std::integral_constant<int, 1>{}); else tiles(std::integral_constant<int, 0>{});
        if (PASS2) {
            __syncthreads();
#pragma unroll
            for (int i = 0; i < 4; ++i) {
                const int e = tid + 512 * i, t = e >> 4, c8 = e & 15;
                const int ho = ((c8 >> 3) * 128 + t) * 64 + (c8 & 7) * 8;
                const u32x4 f = *(const LAS u32x4*)(Hf + ho), b = *(const LAS u32x4*)(Hb + ho), gq = ggr[i];
                u32x4 wq; wq.x = cvt_pk_bf16((bflo(f.x) + bflo(b.x)) * bflo(gq.x), (bfhi(f.x) + bfhi(b.x)) * bfhi(gq.x));
                wq.y = cvt_pk_bf16((bflo(f.y) + bflo(b.y)) * bflo(gq.y), (bfhi(f.y) + bfhi(b.y)) * bfhi(gq.y));
                wq.z = cvt_pk_bf16((bflo(f.z) + bflo(b.z)) * bflo(gq.z), (bfhi(f.z) + bfhi(b.z)) * bfhi(gq.z));
                wq.w = cvt_pk_bf16((bflo(f.w) + bflo(b.w)) * bflo(gq.w), (bfhi(f.w) + bfhi(b.w)) * bfhi(gq.w));
                *(u32x4*)(Z + (size_t)(tok0 + t) * 4096 + 1024 + hp * 128 + c8 * 8) = wq;
            }
        } else {
            if (hh == 0) { const size_t ix = (size_t)(dir * NSC + sc) * 1024 + c; SUMA[ix] = PA; SUMB[ix] = PB; }
            __syncthreads();
        }
    }
}

__device__ __forceinline__ void carry_phase(const Params& p, const int tid, const int bid) {
    const float* SUMA = (const float*)(p.ws + WS_SUMA); float* SUMB = (float*)(p.ws + WS_SUMB);
    for (int idx = bid * 512 + tid; idx < 2 * 40 * 1024; idx += gridDim.x * 512) {
        const int c = idx & 1023, sq = (idx >> 10) % 40, dir = idx / 40960;
        int scb, nch; float s = 0.f;
        if (sq < 32) { scb = 2 * sq; nch = 2; } else { scb = 64 + 32 * (sq - 32); nch = 32; s = (dir ? p.st_b : p.st_f)[(sq - 32) * 1024 + c]; }
        for (int k0 = 0; k0 < nch; k0 += 32) {
            float A[32], B[32];
#pragma unroll
            for (int kk = 0; kk < 32; ++kk) { const int k = k0 + kk; if (k < nch) { const int ch = dir ? nch - 1 - k : k; const size_t ix = (size_t)(dir * NSC + scb + ch) * 1024 + c; A[kk] = SUMA[ix]; B[kk] = SUMB[ix]; } else { A[kk] = 1.f; B[kk] = 0.f; } }
#pragma unroll
            for (int kk = 0; kk < 32; ++kk) { const int k = k0 + kk; if (k < nch) { const int ch = dir ? nch - 1 - k : k; const size_t ix = (size_t)(dir * NSC + scb + ch) * 1024 + c; SUMB[ix] = s; s = A[kk] * s + B[kk]; } }
        }
        if (sq < 32) p.out[(dir ? OUT_SB : OUT_SF) + sq * 1024 + c] = s;
    }
}

__device__ __forceinline__ void gmlp_phase(const Params& p, unsigned char* shm, const int tid, const int bid) {
    bf16_t* VnT = (bf16_t*)shm;
    bf16_t* OT = (bf16_t*)(shm + 34816);
    float* rstd = (float*)(shm + 2 * 34816);
    const int lane = tid & 63, w = tid >> 6, pb = w & 3, chh = w >> 2, hh = lane >> 5, l31 = lane & 31;
    const int G8 = gridDim.x >> 3, g = bid & 7;
    bf16_t* Z = (bf16_t*)(p.ws + WS_Z);
    const float* VSS = (const float*)(p.ws + WS_VSS);
    bf16x8 Af[8];
    { const bf16_t* wrow = (const bf16_t*)(p.ws + WS_WS) + ((size_t)g * 128 + pb * 32 + l31) * 128 + hh * 8;
#pragma unroll
        for (int ks = 0; ks < 8; ++ks) Af[ks] = *(const bf16x8*)(wrow + ks * 16); }
    float bsv[16];
#pragma unroll
    for (int i = 0; i < 16; ++i) bsv[i] = p.b_s[g * 128 + pb * 32 + (i & 3) + 8 * (i >> 2) + 4 * hh];
    f32x4 gnv[4][2];
#pragma unroll
    for (int i = 0; i < 4; ++i) { const int cc = ((tid >> 7) + 4 * i) * 8; gnv[i][0] = *(const f32x4*)(p.gmlp_norm + g * 128 + cc); gnv[i][1] = *(const f32x4*)(p.gmlp_norm + g * 128 + cc + 4); }
    const int qp = tid & 63, cgq = tid >> 6;
    f32x4 gnp[2][2];
#pragma unroll
    for (int i = 0; i < 2; ++i) { const int cc = (cgq + 8 * i) * 8; gnp[i][0] = *(const f32x4*)(p.gmlp_norm + g * 128 + cc); gnp[i][1] = *(const f32x4*)(p.gmlp_norm + g * 128 + cc + 4); }
    u32x4 raw[2][2]; f32x4 vs[4]; u32x4 gu[4], gun[4];
    auto load_v = [&](int sc) {
        const int tok0 = sc * 128;
#pragma unroll
        for (int i = 0; i < 2; ++i)
#pragma unroll
            for (int h = 0; h < 2; ++h) raw[i][h] = *(const u32x4*)(Z + (size_t)(tok0 + 2 * qp + h) * 4096 + 3072 + g * 128 + (cgq + 8 * i) * 8);
        if (tid < 128) { const f32x4* vp = (const f32x4*)(VSS + (size_t)(tok0 + tid) * 16); vs[0] = vp[0]; vs[1] = vp[1]; vs[2] = vp[2]; vs[3] = vp[3]; }
#pragma unroll
        for (int i = 0; i < 4; ++i) { const int e = tid + 512 * i; gun[i] = *(const u32x4*)(Z + (size_t)(tok0 + (e >> 4)) * 4096 + 2048 + g * 128 + (e & 15) * 8); }
    };
    int sc = bid >> 3;
    if (sc < NSC) load_v(sc);
    for (; sc < NSC; sc += G8) {
        const int tok0 = sc * 128;
        if (tid < 128) { const f32x4 a = vs[0] + vs[1] + vs[2] + vs[3]; rstd[tid] = __builtin_amdgcn_rsqf((a[0] + a[1] + a[2] + a[3]) * (1.0f / 1024.0f) + 1e-6f); }
#pragma unroll
        for (int i = 0; i < 4; ++i) gu[i] = gun[i];
        __syncthreads();
        { const float rs0 = rstd[2 * qp], rs1 = rstd[2 * qp + 1];
#pragma unroll
            for (int i = 0; i < 2; ++i) { unsigned* vp = (unsigned*)(VnT + (cgq + 8 * i) * 8 * 136 + 2 * qp); const u32x4 a4 = raw[i][0], b4 = raw[i][1];
                const f32x4 g0 = gnp[i][0], g1 = gnp[i][1];
                vp[0 * 68] = cvt_pk_bf16(bflo(a4.x) * rs0 * g0[0], bflo(b4.x) * rs1 * g0[0]); vp[1 * 68] = cvt_pk_bf16(bfhi(a4.x) * rs0 * g0[1], bfhi(b4.x) * rs1 * g0[1]);
                vp[2 * 68] = cvt_pk_bf16(bflo(a4.y) * rs0 * g0[2], bflo(b4.y) * rs1 * g0[2]); vp[3 * 68] = cvt_pk_bf16(bfhi(a4.y) * rs0 * g0[3], bfhi(b4.y) * rs1 * g0[3]);
                vp[4 * 68] = cvt_pk_bf16(bflo(a4.z) * rs0 * g1[0], bflo(b4.z) * rs1 * g1[0]); vp[5 * 68] = cvt_pk_bf16(bfhi(a4.z) * rs0 * g1[1], bfhi(b4.z) * rs1 * g1[1]);
                vp[6 * 68] = cvt_pk_bf16(bflo(a4.w) * rs0 * g1[2], bflo(b4.w) * rs1 * g1[2]); vp[7 * 68] = cvt_pk_bf16(bfhi(a4.w) * rs0 * g1[3], bfhi(b4.w) * rs1 * g1[3]); } }
        __syncthreads();
        if (sc + G8 < NSC) load_v(sc + G8);
        f32x16 acc0, acc1;
#pragma unroll
        for (int i = 0; i < 16; ++i) { acc0[i] = bsv[i]; acc1[i] = bsv[i]; }
        const bf16_t* v0p = VnT + (chh * 64 + l31) * 136 + hh * 8;
#pragma unroll
        for (int ks = 0; ks < 8; ++ks) {
            const bf16x8 b0 = *(const bf16x8*)(v0p + ks * 16), b1 = *(const bf16x8*)(v0p + 32 * 136 + ks * 16);
            acc0 = __builtin_amdgcn_mfma_f32_32x32x16_bf16(Af[ks], b0, acc0, 0, 0, 0);
            acc1 = __builtin_amdgcn_mfma_f32_32x32x16_bf16(Af[ks], b1, acc1, 0, 0, 0);
        }
#pragma unroll
        for (int i = 0; i < 16; ++i) { const int pr = pb * 32 + (i & 3) + 8 * (i >> 2) + 4 * hh;
            OT[pr * 136 + chh * 64 + l31] = f2bf(acc0[i]); OT[pr * 136 + chh * 64 + 32 + l31] = f2bf(acc1[i]); }
        __syncthreads();
#pragma unroll
        for (int i = 0; i < 4; ++i) { const int e = tid + 512 * i, pr = e >> 4, c8 = e & 15;
            const u32x4 o = *(const u32x4*)(OT + pr * 136 + c8 * 8), u4 = gu[i];
            u32x4 wq; wq.x = cvt_pk_bf16(bflo(o.x) * bflo(u4.x), bfhi(o.x) * bfhi(u4.x)); wq.y = cvt_pk_bf16(bflo(o.y) * bflo(u4.y), bfhi(o.y) * bfhi(u4.y));
            wq.z = cvt_pk_bf16(bflo(o.z) * bflo(u4.z), bfhi(o.z) * bfhi(u4.z)); wq.w = cvt_pk_bf16(bflo(o.w) * bflo(u4.w), bfhi(o.w) * bfhi(u4.w));
            *(u32x4*)(Z + (size_t)(tok0 + pr) * 4096 + 2048 + g * 128 + c8 * 8) = wq; }
    }
}

#define XB_TMO      128
#define XB_XCNT(j)  (256  + 64 * (j))
#define XB_XSUB(j)  (1280 + 64 * (j))
#define XB_XGEN(j)  (2304 + 64 * (j))
#define XB_TOP      3328
#define XB_TOPGEN   3392
#define XCD_BAR_WORDS 3456
#define XB_SPIN_CAP (1u << 18)

__device__ __forceinline__ unsigned xb_ld(unsigned* p)              { return __hip_atomic_load(p, __ATOMIC_RELAXED, __HIP_MEMORY_SCOPE_AGENT); }
__device__ __forceinline__ unsigned xb_add(unsigned* p, unsigned v) { return __hip_atomic_fetch_add(p, v, __ATOMIC_RELAXED, __HIP_MEMORY_SCOPE_AGENT); }
__device__ __forceinline__ unsigned xb_xcc_id() { return (unsigned)__builtin_amdgcn_s_getreg((3 << 11) | 20) & 0xFu; }
#define XB_SPIN(cond, bar) do { unsigned _sp = 0; while (cond) { __builtin_amdgcn_s_sleep(1); \
    if ((++_sp & 255u) == 0u) { if (xb_ld(&(bar)[XB_TMO])) break; if (_sp > XB_SPIN_CAP) { atomicAdd(&(bar)[XB_TMO], 1u); break; } } } } while (0)

struct XcdBarrier {
    unsigned* bar; unsigned x;
    volatile LAS unsigned* st;
};

__device__ __forceinline__ XcdBarrier xcd_barrier_post(unsigned* bar, volatile LAS unsigned* st) {
    XcdBarrier b; b.bar = bar; b.x = xb_xcc_id(); b.st = st;
    if (threadIdx.x == 0) (void)xb_add(&bar[XB_XCNT(b.x)], 1u);
    return b;
}
__device__ __forceinline__ void xcd_barrier_complete(unsigned* bar, unsigned x, unsigned& nloc, unsigned& nx) {
    const unsigned G = gridDim.x * gridDim.y * gridDim.z;
    unsigned sum, cnt, mine, sp = 0u;
    for (;;) {
        sum = 0u; cnt = 0u; mine = 0u;
#pragma unroll
        for (unsigned j = 0; j < 16; ++j) { const unsigned c = xb_ld(&bar[XB_XCNT(j)]); sum += c; cnt += (c > 0u) ? 1u : 0u; mine = (j == x) ? c : mine; }
        if (sum == G) break;
        __builtin_amdgcn_s_sleep(1);
        if ((++sp & 255u) == 0u) { if (xb_ld(&bar[XB_TMO])) break; if (sp > XB_SPIN_CAP) { atomicAdd(&bar[XB_TMO], 1u); break; } }
    }
    nloc = mine > 0u ? mine : 1u; nx = cnt > 0u ? cnt : 1u;
}

__device__ __forceinline__ void xcd_barrier(const XcdBarrier& b) {
    asm volatile("s_waitcnt vmcnt(0)" ::: "memory");
    __syncthreads();
    if (threadIdx.x == 0) {
        unsigned* bar = b.bar;
        __builtin_amdgcn_s_waitcnt(0);
        unsigned nloc = b.st[0], nx = b.st[1];
        if (nloc == 0u) { xcd_barrier_complete(bar, b.x, nloc, nx); b.st[0] = nloc; b.st[1] = nx; }
        const unsigned old = xb_add(&bar[XB_XSUB(b.x)], 1u);
        const unsigned gen = old / nloc;
        if (old + 1u == (gen + 1u) * nloc) {
            __builtin_amdgcn_fence(__ATOMIC_RELEASE, "agent");
            asm volatile("s_waitcnt vmcnt(0)" ::: "memory");
            const unsigned og = xb_add(&bar[XB_TOP], 1u);
            const unsigned tg = og / nx;
            if (og + 1u == (tg + 1u) * nx) xb_add(&bar[XB_TOPGEN], 1u);
            else XB_SPIN(xb_ld(&bar[XB_TOPGEN]) == tg, bar);
            __builtin_amdgcn_fence(__ATOMIC_ACQUIRE, "agent");
            xb_add(&bar[XB_XGEN(b.x)], 1u);
            asm volatile("s_waitcnt vmcnt(0)" ::: "memory");
        } else {
            XB_SPIN(xb_ld(&bar[XB_XGEN(b.x)]) == gen, bar);
            __builtin_amdgcn_fence(__ATOMIC_ACQUIRE, "agent");
            asm volatile("s_waitcnt vmcnt(0)" ::: "memory");
        }
    }
    __syncthreads();
}

__global__ __launch_bounds__(512, 2) void mega(Params p) {
    extern __shared__ __attribute__((aligned(16))) unsigned char shm[];
    cg::grid_group grid = cg::this_grid();
    unsigned char* ws = p.ws;
#if ONE_LAUNCH
    volatile LAS unsigned* bst = (volatile LAS unsigned*)((LAS unsigned char*)shm + 131072);
    if (threadIdx.x == 0) { bst[0] = 0u; bst[1] = 0u; }
    __syncthreads();
    const XcdBarrier xbar = xcd_barrier_post((unsigned*)(ws + WS_BAR), bst);
#endif
    int ph0 = p.ph_lo;
    if (ph0 == 0) {
        int tid = threadIdx.x, bid = blockIdx.x;
        asm volatile("" : "+v"(tid), "+s"(bid));
        prep_phase(p, shm, tid, bid);
        ph0 = 1;
#if ONE_LAUNCH
        if (ph0 < p.ph_hi) xcd_barrier(xbar);
#endif
    }
    for (int ph = ph0; ph < p.ph_hi; ++ph) {
      const int nrep = (ph == PROBE_PH) ? PROBE_REP : 1;
      for (int rep = 0; rep < nrep; ++rep) {
        int tid = threadIdx.x, bid = blockIdx.x;
        asm volatile("" : "+v"(tid), "+s"(bid));
        if (ph == 1) norm_phase<1>(p, nullptr, nullptr, tid, bid);
        else if (ph == 2 || ph == 13) {
            pg8::Gemm g{(const bf16_t*)(ws + WS_HMOD), 1024, (const bf16_t*)(ws + (ph == 2 ? WS_FF1 : WS_FF2)), MTOK, 5632, 1024};
            pg8::StaticOrder S; S.init(MTOK, 5632, gridDim.x, bid, 16);
            EpiSwiGLU E{(bf16_t*)(ws + WS_Z)};
            pg8::gemm_phase((LAS unsigned char*)shm, g, S, E, tid);
        } else if (ph == 3 || ph == 14) {
            pg8::Gemm g{(const bf16_t*)(ws + WS_Z), DFF, (const bf16_t*)(ws + (ph == 3 ? WS_FF1D : WS_FF2D)), MTOK, 1024, DFF};
            pg8::BalancedOrder S; S.init(MTOK, 1024, gridDim.x, bid, 44);
            if (ph == 3) { EpiDelta<false> E{(bf16_t*)p.out, nullptr, (const float*)(ws + WS_MOD) + 2 * 1024, 0.5f, (bf16_t*)(ws + WS_D2)}; pg8::gemm_phase((LAS unsigned char*)shm, g, S, E, tid); }
            else { EpiDelta<true> E{(bf16_t*)(ws + WS_HMOD), (const bf16_t*)p.out, (const float*)(ws + WS_MOD) + 8 * 1024, 0.5f, (bf16_t*)(ws + WS_D2)}; pg8::gemm_phase((LAS unsigned char*)shm, g, S, E, tid); }
        } else if (ph == 4) norm_phase<2>(p, (const bf16_t*)p.out, (bf16_t*)p.out, tid, bid);
        else if (ph == 5) {
            pg8::Gemm g{(const bf16_t*)(ws + WS_HMOD), 1024, (const bf16_t*)(ws + WS_IN), MTOK, 4096, 1024};
            pg8::StaticOrder S; S.init(MTOK, 4096, gridDim.x, bid, 16);
            EpiZ E{(bf16_t*)(ws + WS_Z), (float*)(ws + WS_VSS)};
            pg8::gemm_phase((LAS unsigned char*)shm, g, S, E, tid);
        } else if (ph == 6) scan_phase<false>(p, shm, tid, bid);
        else if (ph == 7) carry_phase(p, tid, bid);
        else if (ph == 8) {
            if ((bid >> 3) & 1) { gmlp_phase(p, shm, tid, bid); __syncthreads(); scan_phase<true>(p, shm, tid, bid); }
            else { scan_phase<true>(p, shm, tid, bid); __syncthreads(); gmlp_phase(p, shm, tid, bid); } }
        else if (ph == 9) {
            pg8::Gemm g{(const bf16_t*)(ws + WS_HMOD), 1024, (const bf16_t*)(ws + WS_IN) + (size_t)4096 * 1024, MTOK, 2048, 1024};
            pg8::StaticOrder S; S.init(MTOK, 2048, gridDim.x, bid, 16);
            EpiGates E{(bf16_t*)(ws + WS_Z)};
            pg8::gemm_phase((LAS unsigned char*)shm, g, S, E, tid);
        } else if (ph == 10) {
            pg8::Gemm g{(const bf16_t*)(ws + WS_Z) + 1024, 4096, (const bf16_t*)(ws + WS_CAT), MTOK, 1024, 2048};
            pg8::StaticOrder S; S.init(MTOK, 1024, gridDim.x, bid, 32);
            EpiMerge E{(const bf16_t*)(ws + WS_Z), (bf16_t*)(ws + WS_HMOD)};
            pg8::gemm_phase((LAS unsigned char*)shm, g, S, E, tid);
            if (gridDim.x == 256 && bid >= 128) transpose_range(ws, shm, tid, bid - 128, 128, 2112, 2);
        } else if (ph == 11) {
            pg8::Gemm g{(const bf16_t*)(ws + WS_HMOD), 1024, (const bf16_t*)(ws + WS_OUT), MTOK, 1024, 1024};
            pg8::BalancedOrder S; S.init(MTOK, 1024, gridDim.x, bid, 16);
            EpiDelta<true> E{(bf16_t*)p.out, (const bf16_t*)p.out, (const float*)(ws + WS_MOD) + 5 * 1024, 1.0f, (bf16_t*)(ws + WS_D2)};
            pg8::gemm_phase((LAS unsigned char*)shm, g, S, E, tid);
        } else if (ph == 12) norm_phase<3>(p, (const bf16_t*)p.out, (bf16_t*)p.out, tid, bid);
        else if (ph == 15) norm_phase<4>(p, (const bf16_t*)(ws + WS_HMOD), nullptr, tid, bid);
#if ONE_LAUNCH
        if (ph + 1 < p.ph_hi || rep + 1 < nrep) { if (p.ph_lo > 1000) grid.sync(); else xcd_barrier(xbar); }
        if (PROBE_SYNCS > 0 && ph == 1) { for (int k = 0; k < PROBE_SYNCS; ++k) xcd_barrier(xbar); }
#endif
      }
    }
}

extern "C" void kernel_launch(void* const* d_in, const int* in_sizes, int n_in, void* d_out, int out_size, void* d_ws, size_t ws_size, hipStream_t stream) {
    static int grid = 0;
    if (grid == 0) {
        if (n_in != 32 || ws_size < WS_END) { fprintf(stderr, "kernel_launch: need 32 inputs and >= %zu bytes of workspace; got n_in %d, ws %zu; nothing launched\n", (size_t)WS_END, n_in, ws_size); grid = -1; return; }
        int dev = 0, cus = 0, per_cu = 0;
        if (hipGetDevice(&dev) != hipSuccess || hipDeviceGetAttribute(&cus, hipDeviceAttributeMultiprocessorCount, dev) != hipSuccess) { grid = -1; return; }
        if (hipFuncSetAttribute((const void*)mega, hipFuncAttributeMaxDynamicSharedMemorySize, LDS_BYTES) != hipSuccess) { fprintf(stderr, "kernel_launch: hipFuncSetAttribute failed\n"); grid = -1; return; }
        if (hipOccupancyMaxActiveBlocksPerMultiprocessor(&per_cu, (const void*)mega, 512, LDS_BYTES) != hipSuccess || per_cu < 1) { fprintf(stderr, "kernel_launch: occupancy query says %d\n", per_cu); per_cu = 1; }
        (void)hipGetLastError();
        grid = cus;
    }
    if (grid < 0) return;
    Params p{};
    const float** pp = (const float**)&p;
    for (int i = 0; i < 32; ++i) pp[i] = (const float*)d_in[i];
    p.out = (float*)d_out; p.ws = (unsigned char*)d_ws;
#if ONE_LAUNCH
    (void)hipMemsetAsync((unsigned char*)d_ws + WS_BAR, 0, 16384, stream);
    p.ph_lo = 0; p.ph_hi = NPH;
    void* args[] = {&p};
    hipError_t e = hipLaunchCooperativeKernel((const void*)mega, dim3(grid), dim3(512), args, LDS_BYTES, stream);
    if (e != hipSuccess) fprintf(stderr, "kernel_launch: cooperative launch failed: %s (grid %d)\n", hipGetErrorString(e), grid);
#else
    for (int ph = 0; ph < NPH; ++ph) {
        p.ph_lo = ph; p.ph_hi = ph + 1;
        hipLaunchKernelGGL(mega, dim3(grid), dim3(512), LDS_BYTES, stream, p);
    }
#endif
}
```
